# Optimizing an MI355X kernel written in HIP

```python
import math
import jax, jax.numpy as jnp
from jax import lax
import numpy as np

D_MODEL = 2048
BATCH = 8
SEQ = 2048
DEPTH = 1

CHUNK = 64
N_META = 16
EPS = 1e-5
ALPHA = (2 * DEPTH) ** 0.25
BETA = (8 * DEPTH) ** -0.25
MIX_WIDTH = D_MODEL
MIX_A = MIX_WIDTH // 2
MIX_B = MIX_WIDTH - MIX_A
A_HEAD_DIM = 128
A_HEADS = MIX_A // A_HEAD_DIM
A_KV_RANK = 256
IDX_HEADS = 16
IDX_DIM = 64
TOPK_MAX = 256
Q_BLOCK = 128
REL_BUCKETS = 32
REL_MAX_DIST = 128
G_HEADS = 4
G_VAL_DIM = MIX_B // G_HEADS
G_KEY_DIM = G_VAL_DIM // 2
G_GATE_RANK = 16
G_GATE_NORM = 16.0
P_HEADS = 8
P_NKEYS = 128
P_NEXPERTS = P_NKEYS * P_NKEYS
P_QDIM = 256
P_TOPK = 16
P_BLOCK = 256
SPLITS = (A_HEADS * A_HEAD_DIM,
          A_KV_RANK,
          IDX_HEADS * IDX_DIM,
          IDX_DIM,
          IDX_HEADS,
          G_HEADS * G_KEY_DIM,
          G_HEADS * G_KEY_DIM,
          G_HEADS * G_VAL_DIM,
          G_GATE_RANK,
          G_HEADS * G_VAL_DIM)
IN_COLS = sum(SPLITS)

kernel_name = 'hybrid_dsa_gla_peer_stream_encoder'


def layer_norm(x, g, b):
    xf = x.astype(jnp.float32)
    mu = jnp.mean(xf, axis=-1, keepdims=True)
    var = jnp.mean(jnp.square(xf - mu), axis=-1, keepdims=True)
    y = (xf - mu) * lax.rsqrt(var + EPS)
    return (y * g.astype(jnp.float32) + b.astype(jnp.float32)).astype(x.dtype)


def rms_norm_f32(x, g):
    xf = x.astype(jnp.float32)
    return xf * lax.rsqrt(jnp.mean(xf * xf, axis=-1, keepdims=True) + EPS) * g.astype(jnp.float32)


def chunk_id(pos):
    return jnp.where(pos < N_META, 0, 1 + (pos - N_META) // CHUNK)


def t5_bucket(rel):
    nb = REL_BUCKETS // 2
    max_exact = nb // 2
    base = jnp.where(rel > 0, nb, 0)
    n = jnp.abs(rel)
    nf = jnp.maximum(n, 1).astype(jnp.float32)
    large = max_exact + (jnp.log(nf / max_exact) / math.log(REL_MAX_DIST / max_exact)
                         * (nb - max_exact)).astype(jnp.int32)
    large = jnp.minimum(large, nb - 1)
    return base + jnp.where(n < max_exact, n, large)


def dsa_mixer(q, ckv, iq, ik, iw, w_uk, w_uv, rel_bias, topk):
    B, L = q.shape[0], q.shape[1]
    ql = jnp.einsum('blhd,hrd->blhr', q, w_uk) * (A_HEAD_DIM ** -0.5)
    iq = iq * (IDX_DIM ** -0.5)
    iw = iw * (IDX_HEADS ** -0.5)
    nblk = -(-L // Q_BLOCK)
    Lp = nblk * Q_BLOCK

    def to_blocks(a):
        a = jnp.pad(a, [(0, 0), (0, Lp - L)] + [(0, 0)] * (a.ndim - 2))
        return jnp.moveaxis(a.reshape((B, nblk, Q_BLOCK) + a.shape[2:]), 1, 0)

    kpos = jnp.arange(L, dtype=jnp.int32)
    kch = chunk_id(kpos)
    qpos = jnp.arange(Lp, dtype=jnp.int32).reshape(nblk, Q_BLOCK)

    def one_block(args):
        iq_b, iw_b, ql_b, qp = args
        adm = kch[None, :] <= chunk_id(qp)[:, None]
        logit = jnp.einsum('bqhd,bkd->bqhk', iq_b, ik)
        score = jnp.einsum('bqhk,bqh->bqk', jax.nn.relu(logit), iw_b).astype(jnp.float32)
        score = jnp.where(adm[None], score, -jnp.inf)
        _, sel = lax.top_k(score, topk)
        valid = jnp.take_along_axis(jnp.broadcast_to(adm[None], score.shape), sel, axis=-1)
        kv = jax.vmap(lambda c, s: c[s])(ckv, sel)
        bias = rel_bias[t5_bucket(kpos[sel] - qp[None, :, None])]
        logits = (jnp.einsum('bqhr,bqkr->bqhk', ql_b, kv).astype(jnp.float32)
                  + jnp.swapaxes(bias, -1, -2).astype(jnp.float32))
        logits = jnp.where(valid[:, :, None, :], logits, -jnp.inf)
        p = jax.nn.softmax(logits, axis=-1).astype(kv.dtype)
        return jnp.einsum('bqhk,bqkr->bqhr', p, kv)

    ol = lax.map(one_block, (to_blocks(iq), to_blocks(iw), to_blocks(ql), qpos))
    ol = jnp.moveaxis(ol, 0, 1).reshape(B, Lp, A_HEADS, A_KV_RANK)[:, :L]
    o = jnp.einsum('blhr,hrd->blhd', ol, w_uv)
    return o.reshape(B, L, A_HEADS * A_HEAD_DIM)


def gla_mixer(q, k, v, gk, og, norm_g):
    B, L = q.shape[0], q.shape[1]
    lead = CHUNK - N_META
    nC = (L + lead) // CHUNK

    def to_chunks(a):
        a = jnp.pad(a.astype(jnp.float32), [(0, 0), (lead, 0)] + [(0, 0)] * (a.ndim - 2))
        return jnp.moveaxis(a.reshape((B, nC, CHUNK) + a.shape[2:]), 1, 0)

    causal = jnp.tril(jnp.ones((CHUNK, CHUNK), dtype=bool))

    def step(S, inp):
        qc, kc, vc, gc = inp
        b = jnp.cumsum(gc, axis=1)
        o_inter = jnp.einsum('bchd,bhdv->bchv', qc * jnp.exp(b), S)
        diff = b[:, :, None] - b[:, None, :]
        decay = jnp.where(causal[None, :, :, None, None], jnp.exp(jnp.minimum(diff, 0.0)), 0.0)
        A = jnp.einsum('bihd,bjhd,bijhd->bhij', qc, kc, decay)
        o_intra = jnp.einsum('bhij,bjhv->bihv', A, vc)
        b_last = b[:, -1]
        S_new = (jnp.exp(b_last)[..., None] * S
                 + jnp.einsum('bjhd,bjhv->bhdv', kc * jnp.exp(b_last[:, None] - b), vc))
        return S_new, o_inter + o_intra

    S0 = jnp.zeros((B, G_HEADS, G_KEY_DIM, G_VAL_DIM), jnp.float32)
    qs = q * (G_KEY_DIM ** -0.5)
    _, o = lax.scan(step, S0, (to_chunks(qs), to_chunks(k), to_chunks(v), to_chunks(gk)))
    o = jnp.moveaxis(o, 0, 1).reshape(B, nC * CHUNK, G_HEADS, G_VAL_DIM)[:, lead:]
    o = rms_norm_f32(o, norm_g).astype(og.dtype).reshape(B, L, G_HEADS * G_VAL_DIM)
    return o * jax.nn.silu(og)


def peer_ffn(x, w_pq, sub_keys, u_tab, v_tab):
    B, L, D = x.shape
    T = B * L
    nblk = -(-T // P_BLOCK)
    xt = jnp.pad(x.reshape(T, D), ((0, nblk * P_BLOCK - T), (0, 0))).reshape(nblk, P_BLOCK, D)

    def one_block(xb):
        qh = (xb @ w_pq).reshape(P_BLOCK, P_HEADS, 2, P_QDIM // 2)
        s = jnp.einsum('thcd,hcnd->thcn', qh, sub_keys).astype(jnp.float32)
        s1, i1 = lax.top_k(s[:, :, 0], P_TOPK)
        s2, i2 = lax.top_k(s[:, :, 1], P_TOPK)
        cand = (s1[..., :, None] + s2[..., None, :]).reshape(P_BLOCK, P_HEADS, P_TOPK * P_TOPK)
        cidx = (i1[..., :, None] * P_NKEYS + i2[..., None, :]).reshape(P_BLOCK, P_HEADS, P_TOPK * P_TOPK)
        top, pos = lax.top_k(cand, P_TOPK)
        eidx = jnp.take_along_axis(cidx, pos, axis=-1).reshape(P_BLOCK, P_HEADS * P_TOPK)
        g = jax.nn.softmax(top, axis=-1).reshape(P_BLOCK, P_HEADS * P_TOPK).astype(xb.dtype)
        act = jax.nn.gelu(jnp.einsum('td,tkd->tk', xb, u_tab[eidx]))
        return jnp.einsum('tk,tkd->td', g * act, v_tab[eidx])

    y = lax.map(one_block, xt).reshape(nblk * P_BLOCK, D)[:T]
    return y.reshape(B, L, D)


def setup_inputs(seed: int = 0) -> dict:
    key = jax.random.key(seed)
    ks = jax.random.split(key, 20)
    f32 = jnp.float32

    def nrm(k, shape, scale):
        return jax.random.normal(k, shape, f32) * scale

    return {
        'x': nrm(ks[0], (BATCH, SEQ, D_MODEL), 1.0),
        'meta_tokens': nrm(ks[1], (N_META, D_MODEL), 1.0),
        'ln0_g': 1.0 + nrm(ks[2], (D_MODEL,), 0.02),
        'ln0_b': nrm(ks[3], (D_MODEL,), 0.02),
        'rel_bias': nrm(ks[4], (REL_BUCKETS, A_HEADS), 0.5),
        'w_in': nrm(ks[5], (DEPTH, D_MODEL, IN_COLS), D_MODEL ** -0.5),
        'w_uk': nrm(ks[6], (DEPTH, A_HEADS, A_KV_RANK, A_HEAD_DIM), A_HEAD_DIM ** -0.5),
        'w_uv': nrm(ks[7], (DEPTH, A_HEADS, A_KV_RANK, A_HEAD_DIM), A_KV_RANK ** -0.5),
        'w_gk2': nrm(ks[8], (DEPTH, G_GATE_RANK, G_HEADS * G_KEY_DIM), G_GATE_RANK ** -0.5),
        'b_gk': nrm(ks[9], (DEPTH, G_HEADS * G_KEY_DIM), 0.1),
        'gla_norm_g': 1.0 + nrm(ks[10], (DEPTH, G_VAL_DIM), 0.02),
        'w_out': nrm(ks[11], (DEPTH, MIX_WIDTH, D_MODEL), BETA * MIX_WIDTH ** -0.5),
        'ln1_g': 1.0 + nrm(ks[12], (DEPTH, D_MODEL), 0.02),
        'ln1_b': nrm(ks[13], (DEPTH, D_MODEL), 0.02),
        'w_pq': nrm(ks[14], (DEPTH, D_MODEL, P_HEADS * P_QDIM), D_MODEL ** -0.5),
        'sub_keys': nrm(ks[15], (DEPTH, P_HEADS, 2, P_NKEYS, P_QDIM // 2), (P_QDIM // 2) ** -0.5),
        'u_tab': nrm(ks[16], (DEPTH, P_NEXPERTS, D_MODEL), D_MODEL ** -0.5),
        'v_tab': nrm(ks[17], (DEPTH, P_NEXPERTS, D_MODEL), BETA * P_HEADS ** -0.5),
        'ln2_g': 1.0 + nrm(ks[18], (DEPTH, D_MODEL), 0.02),
        'ln2_b': nrm(ks[19], (DEPTH, D_MODEL), 0.02),
    }


def reference(x, meta_tokens, ln0_g, ln0_b, rel_bias, w_in, w_uk, w_uv, w_gk2, b_gk,
              gla_norm_g, w_out, ln1_g, ln1_b, w_pq, sub_keys, u_tab, v_tab, ln2_g, ln2_b):
    B, S, D = x.shape
    L = S + N_META
    topk = min(TOPK_MAX, S // 4)
    offsets = []
    acc = 0
    for w in SPLITS[:-1]:
        acc += w
        offsets.append(acc)
    meta = jnp.broadcast_to(meta_tokens[None].astype(x.dtype), (B, N_META, D))
    h = layer_norm(jnp.concatenate([meta, x], axis=1), ln0_g, ln0_b)
    for l in range(DEPTH):
        proj = h @ w_in[l]
        a_q, a_ckv, i_q, i_k, i_w, g_q, g_k, g_v, g_r, g_o = jnp.split(proj, offsets, axis=-1)
        y_a = dsa_mixer(a_q.reshape(B, L, A_HEADS, A_HEAD_DIM), a_ckv,
                        i_q.reshape(B, L, IDX_HEADS, IDX_DIM), i_k, i_w,
                        w_uk[l], w_uv[l], rel_bias, topk)
        gk = jax.nn.log_sigmoid((g_r @ w_gk2[l] + b_gk[l]).astype(jnp.float32)) / G_GATE_NORM
        y_b = gla_mixer(g_q.reshape(B, L, G_HEADS, G_KEY_DIM), g_k.reshape(B, L, G_HEADS, G_KEY_DIM),
                        g_v.reshape(B, L, G_HEADS, G_VAL_DIM), gk.reshape(B, L, G_HEADS, G_KEY_DIM),
                        g_o, gla_norm_g[l])
        mix = jnp.concatenate([y_a, y_b], axis=-1) @ w_out[l]
        h = layer_norm(ALPHA * h + mix, ln1_g[l], ln1_b[l])
        h = layer_norm(ALPHA * h + peer_ffn(h, w_pq[l], sub_keys[l], u_tab[l], v_tab[l]), ln2_g[l], ln2_b[l])
    return h[:, N_META:]
```

```cpp
#include <hip/hip_runtime.h>
#include <cstdio>
#include <cstdint>

#define LAS __attribute__((address_space(3)))
#define GAS __attribute__((address_space(1)))
typedef unsigned short bf16_t;
typedef short bf16x8 __attribute__((ext_vector_type(8)));
typedef short s16x4 __attribute__((ext_vector_type(4)));
typedef float f32x2 __attribute__((ext_vector_type(2)));
typedef float f32x4 __attribute__((ext_vector_type(4)));
typedef float f32x16 __attribute__((ext_vector_type(16)));
typedef unsigned u32x2 __attribute__((ext_vector_type(2)));
typedef unsigned u32x4 __attribute__((ext_vector_type(4)));

constexpr int DM = 2048, NB = 8, SEQ = 2048, NMETA = 16, T = NB * SEQ, TM = T + 256;
constexpr int INC = 5472, INP = 5632;
constexpr int C_AQ = 0, C_CKV = 1024, C_IQ = 1280, C_IK = 2304, C_IW = 2368, C_GQ = 2384, C_GK = 2896, C_GV = 3408, C_GR = 4432, C_GO = 4448;
constexpr int NEXP = 16384;
constexpr float LN_EPS = 1e-5f, ALPHA = 1.189207115002721f, LOG2E = 1.4426950408889634f;
constexpr int NCH = 33;
constexpr int PCH = 8192;

constexpr size_t MiB = 1u << 20;
constexpr size_t WS_CTL = 0, CTL_ZERO_BYTES = 64 * 1024;
constexpr size_t WS_BT = 64 * 1024;
constexpr size_t WS_SKB = 256 * 1024;
constexpr size_t WS_WKV = 1 * MiB;
constexpr size_t WS_EB = 2 * MiB;
constexpr size_t WS_GSS = 3 * MiB;
constexpr size_t WS_H0 = 8 * MiB;
constexpr size_t WS_WIN = 73 * MiB;
constexpr size_t WS_SST = 8 * MiB;
constexpr size_t WS_QT = 74 * MiB;
constexpr size_t WS_AT = 90 * MiB + 512 * 1024;
constexpr size_t WS_ST0 = 7 * MiB;
constexpr size_t WS_PROJ = 99 * MiB;
constexpr size_t WS_KVP = 278 * MiB;
constexpr size_t WS_BM = 343 * MiB;
constexpr size_t WS_KTT = 348 * MiB;
constexpr size_t WS_VT = 365 * MiB;
constexpr size_t WS_GLAO = 398 * MiB;
constexpr size_t WS_YMIX = 430 * MiB;
constexpr size_t WS_WPQ = 496 * MiB;
constexpr size_t WS_WO = 504 * MiB;
constexpr size_t WS_H1 = 8 * MiB;
constexpr size_t WS_UF8 = 72 * MiB;
constexpr size_t WS_VF8 = 104 * MiB;
constexpr size_t WS_H1F8 = 136 * MiB;
constexpr size_t WS_EIDX = 200 * MiB;
constexpr size_t WS_GATE = 204 * MiB;
constexpr size_t WS_GTOT = 212 * MiB;
constexpr size_t WS_C = 244 * MiB;
constexpr size_t WS_QH = 244 * MiB;
constexpr size_t WS_END = 512 * MiB;
static_assert(WS_C + (size_t)T * NEXP <= WS_WO, "C vs WoT");

constexpr int RING_BYTES = 135168;
constexpr int LDSCTL_OFF = 139264;
constexpr int LDS_BYTES = 147456;
constexpr int NWAVES = 8, NTHREADS = 512;

#define LDS_WAIT() asm volatile("s_waitcnt lgkmcnt(0)" ::: "memory")
#define VM_WAIT() asm volatile("s_waitcnt vmcnt(0)" ::: "memory")
#define SBAR() __builtin_amdgcn_sched_barrier(0)

typedef __bf16 bf16x2_t __attribute__((ext_vector_type(2)));
__device__ __forceinline__ unsigned cvtpk(float lo, float hi) { const f32x2 v = {lo, hi}; return __builtin_bit_cast(unsigned, __builtin_convertvector(v, bf16x2_t)); }
__device__ __forceinline__ bf16_t f2bf(float f) { return (bf16_t)(cvtpk(f, 0.f) & 0xffffu); }
__device__ __forceinline__ float bf2f(unsigned short b) { return __uint_as_float(((unsigned)b) << 16); }
__device__ __forceinline__ float bflo(unsigned w) { return __uint_as_float(w << 16); }
__device__ __forceinline__ float bfhi(unsigned w) { return __uint_as_float(w & 0xffff0000u); }
__device__ __forceinline__ float wave_sum(float v) {
#pragma unroll
    for (int o = 1; o < 64; o <<= 1) v += __shfl_xor(v, o);
    return v;
}
__device__ __forceinline__ int crow(int r, int hi) { return (r & 3) + 8 * (r >> 2) + 4 * hi; }

#define XB_TMO      128
#define XB_XCNT(j)  (256  + 64 * (j))
#define XB_XSUB(j)  (1280 + 64 * (j))
#define XB_XGEN(j)  (2304 + 64 * (j))
#define XB_TOP      3328
#define XB_TOPGEN   3392
#define XCD_BAR_WORDS 3456
#define XB_SPIN_CAP (1u << 18)
__device__ __forceinline__ unsigned xb_ld(unsigned* p)              { return __hip_atomic_load(p, __ATOMIC_RELAXED, __HIP_MEMORY_SCOPE_AGENT); }
__device__ __forceinline__ unsigned xb_add(unsigned* p, unsigned v) { return __hip_atomic_fetch_add(p, v, __ATOMIC_RELAXED, __HIP_MEMORY_SCOPE_AGENT); }
__device__ __forceinline__ unsigned xb_xcc_id() { return (unsigned)__builtin_amdgcn_s_getreg((3 << 11) | 20) & 0xFu; }
#define XB_SPIN(cond, bar) do { unsigned _sp = 0; while (cond) { __builtin_amdgcn_s_sleep(1); \
    if ((++_sp & 255u) == 0u) { if (xb_ld(&(bar)[XB_TMO])) break; if (_sp > XB_SPIN_CAP) { atomicAdd(&(bar)[XB_TMO], 1u); break; } } } } while (0)
struct XcdBarrier { unsigned* bar; unsigned x; volatile LAS unsigned* st; };
__device__ __forceinline__ XcdBarrier xcd_barrier_post(unsigned* bar, volatile LAS unsigned* st) {
    XcdBarrier b; b.bar = bar; b.x = xb_xcc_id(); b.st = st;
    if (threadIdx.x == 0) (void)xb_add(&bar[XB_XCNT(b.x)], 1u);
    return b;
}
__device__ __forceinline__ void xcd_barrier_complete(unsigned* bar, unsigned x, unsigned& nloc, unsigned& nx) {
    const unsigned G = gridDim.x * gridDim.y * gridDim.z;
    unsigned sum, cnt, mine, sp = 0u;
    for (;;) {
        sum = 0u; cnt = 0u; mine = 0u;
#pragma unroll
        for (unsigned j = 0; j < 16; ++j) { const unsigned c = xb_ld(&bar[XB_XCNT(j)]); sum += c; cnt += (c > 0u) ? 1u : 0u; mine = (j == x) ? c : mine; }
        if (sum == G) break;
        __builtin_amdgcn_s_sleep(1);
        if ((++sp & 255u) == 0u) { if (xb_ld(&bar[XB_TMO])) break; if (sp > XB_SPIN_CAP) { atomicAdd(&bar[XB_TMO], 1u); break; } }
    }
    nloc = mine > 0u ? mine : 1u; nx = cnt > 0u ? cnt : 1u;
}
__device__ __forceinline__ void xcd_barrier(const XcdBarrier& b) {
    asm volatile("s_waitcnt vmcnt(0)" ::: "memory");
    __syncthreads();
    if (threadIdx.x == 0) {
        unsigned* bar = b.bar;
        __builtin_amdgcn_s_waitcnt(0);
        unsigned nloc = b.st[0], nx = b.st[1];
        if (nloc == 0u) { xcd_barrier_complete(bar, b.x, nloc, nx); b.st[0] = nloc; b.st[1] = nx; }
        const unsigned old = xb_add(&bar[XB_XSUB(b.x)], 1u);
        const unsigned gen = old / nloc;
        if (old + 1u == (gen + 1u) * nloc) {
            __builtin_amdgcn_fence(__ATOMIC_RELEASE, "agent");
            asm volatile("s_waitcnt vmcnt(0)" ::: "memory");
            const unsigned og = xb_add(&bar[XB_TOP], 1u);
            const unsigned tg = og / nx;
            if (og + 1u == (tg + 1u) * nx) xb_add(&bar[XB_TOPGEN], 1u);
            else XB_SPIN(xb_ld(&bar[XB_TOPGEN]) == tg, bar);
            __builtin_amdgcn_fence(__ATOMIC_ACQUIRE, "agent");
            xb_add(&bar[XB_XGEN(b.x)], 1u);
            asm volatile("s_waitcnt vmcnt(0)" ::: "memory");
        } else {
            XB_SPIN(xb_ld(&bar[XB_XGEN(b.x)]) == gen, bar);
            __builtin_amdgcn_fence(__ATOMIC_ACQUIRE, "agent");
            asm volatile("s_waitcnt vmcnt(0)" ::: "memory");
        }
    }
    __syncthreads();
}

namespace pg8 {
constexpr int BM = 256, BK = 64, HALF = 128, HTB = HALF * BK * 2, STAGE_BYTES = 8 * HTB, NXCD = 8, WGM = 8;
__host__ __device__ __forceinline__ int lds_byte(int r, int c) { const int st = (r >> 4) * 2 + (c >> 5), rr = r & 15, cc = c & 31, ob = rr * 64 + cc * 2; return st * 1024 + (ob ^ (((ob >> 9) & 1) << 5)); }
__host__ __device__ __forceinline__ void stage_rc(int b, int& R, int& C) { const int st = b / 1024, sb = b % 1024, swz = sb ^ (((sb >> 9) & 1) << 5); R = (st >> 1) * 16 + swz / 64; C = (st & 1) * 32 + (swz % 64) / 2; }
__host__ __device__ __forceinline__ int perm32(int rho) { const int n = rho >> 4, i = rho & 15; return 8 * (i >> 2) + 4 * n + (i & 3); }
struct Unit { int pm, pn; };
struct Gemm { const bf16_t* A; const bf16_t* Bt; int M, N, K, lda, ldb; };
struct StaticOrder {
    int nM, nN, nwg, G, c;
    __host__ __device__ void init(int M, int N, int G_, int c_) { nM = M / BM; nN = N / BM; nwg = nM * nN; G = G_; c = c_; }
    __host__ __device__ bool next(int i, Unit& u) const {
        const long L = (long)i * G + c; if (L >= nwg) return false;
        int wgid = (int)L; { const int q = nwg / NXCD, r = nwg % NXCD, xcd = wgid % NXCD, off = wgid / NXCD; wgid = (xcd < r ? xcd * (q + 1) : r * (q + 1) + (xcd - r) * q) + off; }
        const int nig = WGM * nN, gid = wgid / nig, fm = gid * WGM, gsz = (nM - fm) < WGM ? (nM - fm) : WGM;
        u.pm = fm + ((wgid % nig) % gsz); u.pn = (wgid % nig) / gsz; return true;
    }
};
struct EpiBf16 {
    static constexpr bool PERM = true;
    bf16_t* O; int ldc; float sc;
    __device__ __forceinline__ void operator()(const f32x4 (&acc)[2][2][4][2], const Unit& u, int wr, int wc, int fr, int fq) const {
        const int row0 = u.pm * BM + wr * 64 + fr, col0 = u.pn * BM + wc * 32 + 8 * fq;
#pragma unroll
        for (int ai = 0; ai < 2; ++ai)
#pragma unroll
            for (int m = 0; m < 4; ++m) { bf16_t* rowp = O + (size_t)(row0 + ai * HALF + m * 16) * ldc + col0;
#pragma unroll
                for (int bj = 0; bj < 2; ++bj) { const f32x4 v0 = acc[ai][bj][m][0] * sc, v1 = acc[ai][bj][m][1] * sc;
                    u32x4 w; w.x = cvtpk(v0[0], v0[1]); w.y = cvtpk(v0[2], v0[3]); w.z = cvtpk(v1[0], v1[1]); w.w = cvtpk(v1[2], v1[3]);
                    *(u32x4*)(rowp + bj * HALF) = w; } }
    }
};
struct EpiResF32 {
    static constexpr bool PERM = false;
    float* out; int ldc; const bf16_t* base; int ldbase; float alpha; float sc;
    __device__ __forceinline__ void operator()(const f32x4 (&acc)[2][2][4][2], const Unit& u, int wr, int wc, int fr, int fq) const {
        const int row0 = u.pm * BM + wr * 64 + fr, col0 = u.pn * BM + wc * 32 + 4 * fq;
#pragma unroll
        for (int ai = 0; ai < 2; ++ai)
#pragma unroll
            for (int m = 0; m < 4; ++m) { const size_t row = (size_t)(row0 + ai * HALF + m * 16);
#pragma unroll
                for (int bj = 0; bj < 2; ++bj)
#pragma unroll
                    for (int n = 0; n < 2; ++n) { const int c = col0 + bj * HALF + n * 16;
                        const u32x2 bw = *(const u32x2*)(base + row * ldbase + c);
                        f32x4 o = acc[ai][bj][m][n] * sc;
                        o[0] += alpha * bflo(bw.x); o[1] += alpha * bfhi(bw.x); o[2] += alpha * bflo(bw.y); o[3] += alpha * bfhi(bw.y);
                        *(f32x4*)(out + row * ldc + c) = o; } }
    }
};
struct EpiResLn0 {
    static constexpr bool PERM = false;
    float* out; int ldc; const float* x; const float* st; const float* g; const float* b; float alpha;
    __device__ __forceinline__ void operator()(const f32x4 (&acc)[2][2][4][2], const Unit& u, int wr, int wc, int fr, int fq) const {
        const int row0 = u.pm * BM + wr * 64 + fr, col0 = u.pn * BM + wc * 32 + 4 * fq;
        f32x4 gg[2][2], bb[2][2];
#pragma unroll
        for (int bj = 0; bj < 2; ++bj)
#pragma unroll
            for (int n = 0; n < 2; ++n) { gg[bj][n] = *(const f32x4*)(g + col0 + bj * HALF + n * 16) * alpha; bb[bj][n] = *(const f32x4*)(b + col0 + bj * HALF + n * 16) * alpha; }
#pragma unroll
        for (int ai = 0; ai < 2; ++ai)
#pragma unroll
            for (int m = 0; m < 4; ++m) { const size_t row = (size_t)(row0 + ai * HALF + m * 16); const f32x2 ms = *(const f32x2*)(st + 2 * row);
#pragma unroll
                for (int bj = 0; bj < 2; ++bj)
#pragma unroll
                    for (int n = 0; n < 2; ++n) { const int c = col0 + bj * HALF + n * 16;
                        const f32x4 xv = *(const f32x4*)(x + row * ldc + c);
                        *(f32x4*)(out + row * ldc + c) = acc[ai][bj][m][n] + ((xv - ms.x) * ms.y) * gg[bj][n] + bb[bj][n]; } }
    }
};
__device__ __forceinline__ float gelu_exact(float v) {
    const float av = fabsf(v), t = __builtin_amdgcn_rcpf(av * 0.2316418882f + 1.0f);
    float q = t * 0.5307027145f + (-0.7265760135f); q = q * t + 0.7107068705f; q = q * t + (-0.142248368f); q = q * t + 0.127414796f; q = q * t;
    const float e = __builtin_amdgcn_exp2f((v * v) * (-0.72134752044f));
    const float m = v * (q * e);
    return v < 0.f ? m : v - m;
}
constexpr float PEER_SU = 64.f, PEER_SV = 8.f, PEER_SC = 64.f;
struct EpiPeer {
    static constexpr bool PERM = true;
    unsigned char* O; int ldc; const float* gtot; float su_inv;
    __device__ __forceinline__ void operator()(const f32x4 (&acc)[2][2][4][2], const Unit& u, int wr, int wc, int fr, int fq) const {
        const int row0 = u.pm * BM + wr * 64 + fr, col0 = u.pn * BM + wc * 32 + 8 * fq;
#pragma unroll
        for (int ai = 0; ai < 2; ++ai) {
            u32x2 gw[4][2];
#pragma unroll
            for (int m = 0; m < 4; ++m)
#pragma unroll
                for (int bj = 0; bj < 2; ++bj) gw[m][bj] = *(const u32x2*)(O + (size_t)(row0 + ai * HALF + m * 16) * ldc + col0 + bj * HALF);
#pragma unroll
            for (int m = 0; m < 4; ++m)
#pragma unroll
                for (int bj = 0; bj < 2; ++bj) { const u32x2 g = gw[m][bj];
                    if ((g.x | g.y) != 0u) { const size_t row = (size_t)(row0 + ai * HALF + m * 16); const float* gt = gtot + row * 128;
                        const f32x4 v0 = acc[ai][bj][m][0], v1 = acc[ai][bj][m][1];
                        float o[8];
#pragma unroll
                        for (int j = 0; j < 4; ++j) { const unsigned b0 = (g.x >> (8 * j)) & 255u, b1 = (g.y >> (8 * j)) & 255u;
                            o[j] = b0 ? gt[b0 - 1] * PEER_SC * gelu_exact(v0[j] * su_inv) : 0.f; o[4 + j] = b1 ? gt[b1 - 1] * PEER_SC * gelu_exact(v1[j] * su_inv) : 0.f; }
                        int w0 = 0, w1 = 0;
                        w0 = __builtin_amdgcn_cvt_pk_fp8_f32(o[0], o[1], w0, false); w0 = __builtin_amdgcn_cvt_pk_fp8_f32(o[2], o[3], w0, true);
                        w1 = __builtin_amdgcn_cvt_pk_fp8_f32(o[4], o[5], w1, false); w1 = __builtin_amdgcn_cvt_pk_fp8_f32(o[6], o[7], w1, true);
                        *(u32x2*)(O + row * ldc + col0 + bj * HALF) = (u32x2){(unsigned)w0, (unsigned)w1}; } }
        }
    }
};

typedef int v8i_t __attribute__((ext_vector_type(8)));
typedef int v4i_t __attribute__((ext_vector_type(4)));
template <class Epi, bool ALIGN_EPI, bool F8 = false>
__device__ __forceinline__ void gemm_phase(LAS unsigned char* lds, const Gemm g, const StaticOrder& S, const Epi& E) {
    const int tid = threadIdx.x, wid = __builtin_amdgcn_readfirstlane(tid >> 6), lane = tid & 63, wr = wid >> 2, wc = wid & 3, fr = lane & 15, fq = lane >> 4;
    const int K = g.K, nt = K / BK;
    unsigned voffA[2], voffB[2];
#pragma unroll
    for (int i = 0; i < 2; ++i) { int R, C; stage_rc(tid * 16 + i * 8192, R, C); const int Rb = Epi::PERM ? ((R & ~31) + perm32(R & 31)) : R;
        voffA[i] = (unsigned)(R * g.lda + C) * 2u; voffB[i] = (unsigned)(Rb * g.ldb + C) * 2u; }
    const size_t kstep = (size_t)(BK * 2);
    const size_t hstepA = (size_t)HALF * g.lda * 2, hstepB = (size_t)HALF * g.ldb * 2;
    const size_t tstepA = 2 * hstepA, tstepB = 2 * hstepB;
    const unsigned ldsw = (unsigned)wid * 1024u;
    const int aoff = lds_byte(wr * 64 + fr, fq * 8), boff = lds_byte(wc * 32 + fr, fq * 8);
#define PG8_SA(b, h) (((b) * 2 + (h)) * HTB)
#define PG8_SB(b, h) ((4 + (b) * 2 + (h)) * HTB)
#define PG8_STAGE(bufoff, gbase, voff) do { _Pragma("unroll") for (int _i = 0; _i < 2; ++_i) \
        __builtin_amdgcn_global_load_lds((const unsigned*)((const char*)(gbase) + (voff)[_i]), (LAS unsigned*)(lds + (bufoff) + ldsw + _i * 8192), 16, 0, 0); } while (0)
#define PG8_LDA(dst, b, h) do { _Pragma("unroll") for (int m = 0; m < 4; ++m) _Pragma("unroll") for (int k = 0; k < 2; ++k) dst[m][k] = *(const LAS bf16x8*)(lds + PG8_SA(b, h) + aoff + m * 2048 + k * 1024); } while (0)
#define PG8_LDB(dst, b, h) do { _Pragma("unroll") for (int n = 0; n < 2; ++n) _Pragma("unroll") for (int k = 0; k < 2; ++k) dst[n][k] = *(const LAS bf16x8*)(lds + PG8_SB(b, h) + boff + n * 2048 + k * 1024); } while (0)
#define PG8_CAT(x) __builtin_shufflevector(__builtin_bit_cast(v4i_t, x[0]), __builtin_bit_cast(v4i_t, x[1]), 0, 1, 2, 3, 4, 5, 6, 7)
#define PG8_MMA(ai, bj, At, Bt) do { __builtin_amdgcn_s_setprio(1); \
        if constexpr (F8) { _Pragma("unroll") for (int m = 0; m < 4; ++m) _Pragma("unroll") for (int n = 0; n < 2; ++n) \
            asm volatile("v_mfma_scale_f32_16x16x128_f8f6f4 %0, %1, %2, %0, %3, %3 op_sel_hi:[0,0,0]" : "+v"(acc[ai][bj][m][n]) : "v"(PG8_CAT(Bt[n])), "v"(PG8_CAT(At[m])), "v"(f8one)); } \
        else { _Pragma("unroll") for (int m = 0; m < 4; ++m) _Pragma("unroll") for (int n = 0; n < 2; ++n) _Pragma("unroll") for (int k = 0; k < 2; ++k) \
            acc[ai][bj][m][n] = __builtin_amdgcn_mfma_f32_16x16x32_bf16(Bt[n][k], At[m][k], acc[ai][bj][m][n], 0, 0, 0); } \
        __builtin_amdgcn_s_setprio(0); } while (0)
#define PG8_WAIT_V(n) asm volatile("s_waitcnt vmcnt(" #n ")" ::: "memory")
#define PG8_WAIT_L(n) asm volatile("s_waitcnt lgkmcnt(" #n ")" ::: "memory")
#define PG8_BAR __builtin_amdgcn_s_barrier()
#define PG8_SCHED __builtin_amdgcn_sched_barrier(0)
    Unit cur, nxt; int ui = 0;
    if (!S.next(0, cur)) return;
    const int f8one = 127;
    f32x4 acc[2][2][4][2];
#pragma unroll
    for (int a = 0; a < 2; ++a)
#pragma unroll
        for (int b = 0; b < 2; ++b)
#pragma unroll
            for (int m = 0; m < 4; ++m)
#pragma unroll
                for (int n = 0; n < 2; ++n) acc[a][b][m][n] = (f32x4){0.f, 0.f, 0.f, 0.f};
    bf16x8 At[4][2], B0[2][2], B1[2][2];
    const char* cA = (const char*)g.A + (size_t)cur.pm * tstepA; const char* cB = (const char*)g.Bt + (size_t)cur.pn * tstepB;
    PG8_STAGE(PG8_SB(0, 0), cB, voffB); PG8_STAGE(PG8_SB(0, 1), cB + hstepB, voffB); PG8_STAGE(PG8_SA(0, 0), cA, voffA); PG8_STAGE(PG8_SA(0, 1), cA + hstepA, voffA);
    if (wr == 1) PG8_BAR;
    PG8_WAIT_V(2); PG8_BAR;
    PG8_STAGE(PG8_SB(1, 0), cB + kstep, voffB); PG8_STAGE(PG8_SA(1, 0), cA + kstep, voffA); PG8_STAGE(PG8_SB(1, 1), cB + hstepB + kstep, voffB);
    PG8_WAIT_V(6); PG8_BAR;
    for (;;) {
        const bool has_next = S.next(ui + 1, nxt);
        const char* nA = has_next ? (const char*)g.A + (size_t)nxt.pm * tstepA : cA; const char* nB = has_next ? (const char*)g.Bt + (size_t)nxt.pn * tstepB : cB;
        for (int t = 0; t < nt; t += 2) {
            const bool last = (t == nt - 2);
            const char* a1 = cA + (size_t)(t + 1) * kstep;
            const char* a2 = last ? nA : cA + (size_t)(t + 2) * kstep; const char* b2 = last ? nB : cB + (size_t)(t + 2) * kstep;
            const char* a3 = a2 + kstep; const char* b3 = b2 + kstep;
            PG8_LDB(B0, 0, 0); PG8_LDB(B1, 0, 1); PG8_SCHED; PG8_LDA(At, 0, 0); PG8_STAGE(PG8_SA(1, 1), a1 + hstepA, voffA);
            PG8_WAIT_V(8); PG8_WAIT_L(0); PG8_BAR; PG8_MMA(0, 0, At, B0); PG8_MMA(0, 1, At, B1); PG8_BAR; PG8_SCHED;
            PG8_LDA(At, 0, 1); PG8_STAGE(PG8_SB(0, 0), b2, voffB); PG8_STAGE(PG8_SB(0, 1), b2 + hstepB, voffB); PG8_STAGE(PG8_SA(0, 0), a2, voffA);
            PG8_WAIT_V(8); PG8_WAIT_L(0); PG8_BAR; PG8_MMA(1, 0, At, B0); PG8_MMA(1, 1, At, B1); PG8_BAR; PG8_SCHED;
            PG8_LDB(B0, 1, 0); PG8_LDB(B1, 1, 1); PG8_SCHED; PG8_LDA(At, 1, 0); PG8_STAGE(PG8_SA(0, 1), a2 + hstepA, voffA);
            PG8_WAIT_V(8); PG8_WAIT_L(0); PG8_BAR; PG8_MMA(0, 0, At, B0); PG8_MMA(0, 1, At, B1); PG8_BAR; PG8_SCHED;
            PG8_LDA(At, 1, 1); PG8_STAGE(PG8_SB(1, 0), b3, voffB); PG8_STAGE(PG8_SB(1, 1), b3 + hstepB, voffB); PG8_STAGE(PG8_SA(1, 0), a3, voffA);
            PG8_WAIT_V(8); PG8_WAIT_L(0); PG8_BAR; PG8_MMA(1, 0, At, B0); PG8_MMA(1, 1, At, B1); PG8_BAR; PG8_SCHED;
        }
        if constexpr (ALIGN_EPI) { if (wr == 0) PG8_BAR; }
        if constexpr (F8) { asm volatile("s_nop 15\n\ts_nop 15" ::: "memory"); }
        E(acc, cur, wr, wc, fr, fq);
        if (!has_next) break;
#pragma unroll
        for (int a = 0; a < 2; ++a)
#pragma unroll
            for (int b = 0; b < 2; ++b)
#pragma unroll
                for (int m = 0; m < 4; ++m)
#pragma unroll
                    for (int n = 0; n < 2; ++n) acc[a][b][m][n] = (f32x4){0.f, 0.f, 0.f, 0.f};
        cur = nxt; cA = nA; cB = nB; ++ui;
        if constexpr (ALIGN_EPI) { if (wr == 1) PG8_BAR; }
    }
    PG8_WAIT_V(0);
    if constexpr (!ALIGN_EPI) { if (wr == 0) PG8_BAR; }
    PG8_BAR;
#undef PG8_SA
#undef PG8_SB
#undef PG8_STAGE
#undef PG8_LDA
#undef PG8_LDB
#undef PG8_MMA
#undef PG8_CAT
#undef PG8_WAIT_V
#undef PG8_WAIT_L
#undef PG8_BAR
#undef PG8_SCHED
}
}

struct Frame {
    LAS unsigned char* lds;
    int tid, lane, wave, G, gw, ngw;
    const float* in[20];
    float* out; unsigned char* ws;
};
enum { I_X = 0, I_META, I_LN0G, I_LN0B, I_RELB, I_WIN, I_WUK, I_WUV, I_WGK2, I_BGK, I_GNG, I_WOUT, I_LN1G, I_LN1B, I_WPQ, I_SUBK, I_UTAB, I_VTAB, I_LN2G, I_LN2B };

__device__ __forceinline__ void ln_stats(f32x4 (&v)[8], float& mean, float& rstd) {
    float s = 0.f;
#pragma unroll
    for (int j = 0; j < 8; ++j) s += (v[j].x + v[j].y) + (v[j].z + v[j].w);
    mean = wave_sum(s) * (1.f / DM); float s2 = 0.f;
#pragma unroll
    for (int j = 0; j < 8; ++j) { v[j] = v[j] - mean; s2 += (v[j].x * v[j].x + v[j].y * v[j].y) + (v[j].z * v[j].z + v[j].w * v[j].w); }
    rstd = 1.f / sqrtf(wave_sum(s2) * (1.f / DM) + LN_EPS);
}
__device__ __forceinline__ void ln_row_to_bf16(const float* xrow, const float* g, const float* b, bf16_t* orow, int lane, unsigned* f8row = nullptr, float* stats = nullptr) {
    const f32x4* xr = (const f32x4*)xrow + lane; f32x4 v[8];
#pragma unroll
    for (int j = 0; j < 8; ++j) v[j] = xr[64 * j];
    float mean, rstd; ln_stats(v, mean, rstd);
    if (stats && lane == 0) *(f32x2*)stats = (f32x2){mean, rstd};
    const f32x4* gr = (const f32x4*)g + lane; const f32x4* br = (const f32x4*)b + lane;
    u32x2* o8 = (u32x2*)orow + lane;
#pragma unroll
    for (int j = 0; j < 8; ++j) { const f32x4 gg = gr[64 * j], bb = br[64 * j]; const f32x4 y = v[j] * rstd * gg + bb;
        u32x2 w; w.x = cvtpk(y.x, y.y); w.y = cvtpk(y.z, y.w); o8[64 * j] = w;
        if (f8row) { int q = 0; q = __builtin_amdgcn_cvt_pk_fp8_f32(y.x, y.y, q, false); q = __builtin_amdgcn_cvt_pk_fp8_f32(y.z, y.w, q, true); f8row[lane + 64 * j] = (unsigned)q; } }
}
__device__ __forceinline__ void ln_row_to_f32(const float* xrow, const float* g, const float* b, float* orow, int lane) {
    const f32x4* xr = (const f32x4*)xrow + lane; f32x4 v[8];
#pragma unroll
    for (int j = 0; j < 8; ++j) v[j] = xr[64 * j];
    float mean, rstd; ln_stats(v, mean, rstd);
    const f32x4* gr = (const f32x4*)g + lane; const f32x4* br = (const f32x4*)b + lane;
    f32x4* o = (f32x4*)orow + lane;
#pragma unroll
    for (int j = 0; j < 8; ++j) { const f32x4 gg = gr[64 * j], bb = br[64 * j]; o[64 * j] = v[j] * rstd * gg + bb; }
}
__device__ __forceinline__ void transpose_item(const float* W, int N, bf16_t* WT, int ldt, int row_off, float scale, LAS float* scr, int item, int lane) {
    const int nblk = N / 32, kb = item / nblk, nb = item % nblk, k0 = 64 * kb, n0 = 32 * nb;
#pragma unroll 8
    for (int i = 0; i < 32; ++i) { const int kk = 2 * i + (lane >> 5); scr[kk * 33 + (lane & 31)] = W[(size_t)(k0 + kk) * N + n0 + (lane & 31)]; }
    LDS_WAIT(); asm volatile("" ::: "memory");
    const int c = lane & 7;
#pragma unroll
    for (int j = 0; j < 4; ++j) { const int n = (lane >> 3) + 8 * j; const LAS float* s = scr + (8 * c) * 33 + n;
        u32x4 o; o.x = cvtpk(s[0 * 33] * scale, s[1 * 33] * scale); o.y = cvtpk(s[2 * 33] * scale, s[3 * 33] * scale); o.z = cvtpk(s[4 * 33] * scale, s[5 * 33] * scale); o.w = cvtpk(s[6 * 33] * scale, s[7 * 33] * scale);
        *(u32x4*)(WT + (size_t)(row_off + n0 + n) * ldt + k0 + 8 * c) = o; }
    LDS_WAIT(); asm volatile("" ::: "memory");
}
__device__ __forceinline__ void transpose_item_f8(const float* W, int N, unsigned char* WT, size_t ldt, float scale, LAS float* scr, int item, int lane) {
    const int nblk = N / 32, kb = item / nblk, nb = item % nblk, k0 = 64 * kb, n0 = 32 * nb;
#pragma unroll 8
    for (int i = 0; i < 32; ++i) { const int kk = 2 * i + (lane >> 5); scr[kk * 33 + (lane & 31)] = W[(size_t)(k0 + kk) * N + n0 + (lane & 31)]; }
    LDS_WAIT(); asm volatile("" ::: "memory");
    const int c = lane & 7;
#pragma unroll
    for (int j = 0; j < 4; ++j) { const int n = (lane >> 3) + 8 * j; const LAS float* s = scr + (8 * c) * 33 + n;
        int w0 = 0, w1 = 0;
        w0 = __builtin_amdgcn_cvt_pk_fp8_f32(s[0 * 33] * scale, s[1 * 33] * scale, w0, false); w0 = __builtin_amdgcn_cvt_pk_fp8_f32(s[2 * 33] * scale, s[3 * 33] * scale, w0, true);
        w1 = __builtin_amdgcn_cvt_pk_fp8_f32(s[4 * 33] * scale, s[5 * 33] * scale, w1, false); w1 = __builtin_amdgcn_cvt_pk_fp8_f32(s[6 * 33] * scale, s[7 * 33] * scale, w1, true);
        *(u32x2*)(WT + (size_t)(n0 + n) * ldt + k0 + 8 * c) = (u32x2){(unsigned)w0, (unsigned)w1}; }
    LDS_WAIT(); asm volatile("" ::: "memory");
}
__device__ __forceinline__ void convert_f32_f8(const float* src, unsigned char* dst, float scale, size_t n8, size_t i0, size_t stride) {
    for (size_t i = i0; i < n8; i += stride) { const f32x4 a = ((const f32x4*)src)[2 * i] * scale, b = ((const f32x4*)src)[2 * i + 1] * scale;
        int w0 = 0, w1 = 0;
        w0 = __builtin_amdgcn_cvt_pk_fp8_f32(a.x, a.y, w0, false); w0 = __builtin_amdgcn_cvt_pk_fp8_f32(a.z, a.w, w0, true);
        w1 = __builtin_amdgcn_cvt_pk_fp8_f32(b.x, b.y, w1, false); w1 = __builtin_amdgcn_cvt_pk_fp8_f32(b.z, b.w, w1, true);
        ((u32x2*)dst)[i] = (u32x2){(unsigned)w0, (unsigned)w1}; }
}
__device__ __forceinline__ void convert_f32_bf16(const float* src, bf16_t* dst, size_t n8, size_t i0, size_t stride) {
    for (size_t i = i0; i < n8; i += stride) { const f32x4 a = ((const f32x4*)src)[2 * i], b = ((const f32x4*)src)[2 * i + 1];
        u32x4 w; w.x = cvtpk(a.x, a.y); w.y = cvtpk(a.z, a.w); w.z = cvtpk(b.x, b.y); w.w = cvtpk(b.z, b.w); ((u32x4*)dst)[i] = w; }
}
__device__ __forceinline__ int t5_bucket(int rel) {
    const int n = rel < 0 ? -rel : rel;
    const int f = n < 8 ? n : (n < 12 ? 8 : (n < 16 ? 9 : (n < 23 ? 10 : (n < 32 ? 11 : (n < 46 ? 12 : (n < 64 ? 13 : (n < 91 ? 14 : 15)))))));
    return (rel > 0 ? 16 : 0) + f;
}
constexpr float WPQ_S = 64.f;
constexpr int BT_OFF = 2080, BT_N = 2144;

__device__ __forceinline__ void p0_prologue(Frame& F) {
    LAS float* scr = (LAS float*)(F.lds + F.wave * 8704);
    bf16_t* H0 = (bf16_t*)(F.ws + WS_H0);
    for (int m = F.gw; m < T + NMETA; m += F.ngw) {
        const float* src = m < T ? F.in[I_X] + (size_t)m * DM : F.in[I_META] + (size_t)(m - T) * DM;
        ln_row_to_bf16(src, F.in[I_LN0G], F.in[I_LN0B], H0 + (size_t)m * DM, F.lane, nullptr, m < T ? (float*)(F.ws + WS_ST0) + 2 * (size_t)m : nullptr);
    }
    { u32x4* z = (u32x4*)(H0 + (size_t)(T + NMETA) * DM); const size_t n = (size_t)(TM - T - NMETA) * DM / 8;
      for (size_t i = (size_t)F.gw * 64 + F.lane; i < n; i += (size_t)F.ngw * 64) z[i] = (u32x4){0u, 0u, 0u, 0u}; }
    constexpr int I_IN = (DM / 64) * (INC / 32), I_O = (DM / 64) * (DM / 32), I_KV = 8 * (256 / 64) * (128 / 32);
    constexpr int NITEMS = I_IN + 2 * I_O + 2 * I_KV;
    for (int it = F.gw; it < NITEMS; it += F.ngw) {
        int r = it;
        if (r < I_IN) { transpose_item(F.in[I_WIN], INC, (bf16_t*)(F.ws + WS_WIN), DM, 0, 1.f, scr, r, F.lane); continue; } r -= I_IN;
        if (r < I_O) { transpose_item(F.in[I_WOUT], DM, (bf16_t*)(F.ws + WS_WO), DM, 0, 1.f, scr, r, F.lane); continue; } r -= I_O;
        if (r < I_O) { transpose_item(F.in[I_WPQ], DM, (bf16_t*)(F.ws + WS_WPQ), DM, 0, 1.f, scr, r, F.lane); continue; } r -= I_O;
        if (r < I_KV) { const int h = r / 16; transpose_item(F.in[I_WUK] + (size_t)h * 256 * 128, 128, (bf16_t*)(F.ws + WS_WKV), 256, h * 128, 0.08838834764831845f * LOG2E, scr, r % 16, F.lane); continue; } r -= I_KV;
        { const int h = r / 16; transpose_item(F.in[I_WUV] + (size_t)h * 256 * 128, 128, (bf16_t*)(F.ws + WS_WKV), 256, 1024 + h * 128, 1.f, scr, r % 16, F.lane); }
    }
    convert_f32_bf16(F.in[I_SUBK], (bf16_t*)(F.ws + WS_SKB), (size_t)16 * 128 * 128 / 8, (size_t)F.gw * 64 + F.lane, (size_t)F.ngw * 64);
    { float* bt = (float*)(F.ws + WS_BT);
      for (int i = F.gw * 64 + F.lane; i < 8 * BT_N; i += F.ngw * 64) { const int h = i / BT_N, rel = i % BT_N - BT_OFF; bt[i] = F.in[I_RELB][t5_bucket(rel) * 8 + h] * LOG2E; } }
}

__device__ __forceinline__ void kv_meta(Frame& F) {
    const bf16_t* PROJ = (const bf16_t*)(F.ws + WS_PROJ); const bf16_t* WKV = (const bf16_t*)(F.ws + WS_WKV); bf16_t* KVP = (bf16_t*)(F.ws + WS_KVP);
    const int l16 = F.lane & 15, q4 = F.lane >> 4;
    for (int j = F.gw; j < 128; j += F.ngw) {
        f32x4 acc = {0.f, 0.f, 0.f, 0.f};
#pragma unroll
        for (int s = 0; s < 8; ++s) acc = __builtin_amdgcn_mfma_f32_16x16x32_bf16(*(const bf16x8*)(PROJ + (size_t)(T + l16) * INP + C_CKV + 32 * s + 8 * q4), *(const bf16x8*)(WKV + (size_t)(16 * j + l16) * 256 + 32 * s + 8 * q4), acc, 0, 0, 0);
#pragma unroll
        for (int r = 0; r < 4; ++r) KVP[(size_t)(T + 4 * q4 + r) * 2048 + 16 * j + l16] = f2bf(acc[r]);
    }
    { u32x4* z = (u32x4*)(KVP + (size_t)(T + NMETA) * 2048); const int n = 48 * 2048 / 8;
      for (int i = F.gw * 64 + F.lane; i < n; i += F.ngw * 64) z[i] = (u32x4){0u, 0u, 0u, 0u}; }
}
__device__ __forceinline__ void idx_unit(Frame& F, int b, int g) {
    const bf16_t* PROJ = (const bf16_t*)(F.ws + WS_PROJ);
    unsigned* BM = (unsigned*)(F.ws + WS_BM);
    const int lane = F.lane, n = lane & 31, hi = lane >> 5, w = F.wave;
    const int c = g >> 2, nrt = 2 * (c + 1), ntile = nrt + 1;
    LAS float* scall = (LAS float*)(F.lds);
    LAS float* iwl = (LAS float*)(F.lds + RING_BYTES);
    const float NINF = -__builtin_inff();
    if (F.tid < 256) iwl[F.tid] = bf2f(PROJ[(size_t)(b * SEQ + 16 * g + (F.tid >> 4)) * INP + C_IW + (F.tid & 15)]);
    __syncthreads();
    for (int mh = 0; mh < 2; ++mh) {
        bf16x8 af[4][4];
#pragma unroll
        for (int mt = 0; mt < 4; ++mt)
#pragma unroll
            for (int s = 0; s < 4; ++s) af[mt][s] = *(const bf16x8*)(PROJ + (size_t)(b * SEQ + 16 * g + 2 * (4 * mh + mt) + (n >> 4)) * INP + C_IQ + (n & 15) * 64 + 16 * s + 8 * hi);
        bf16x8 b0[4], b1[4], b2[4];
#define IDX_LOADB(dst, tt) do { const int t_ = (tt); if (t_ < ntile) { const size_t krow_ = t_ < nrt ? (size_t)(b * SEQ + 32 * t_ + n) : (size_t)(T + n); \
            _Pragma("unroll") for (int s = 0; s < 4; ++s) dst[s] = *(const bf16x8*)(PROJ + krow_ * INP + C_IK + 16 * s + 8 * hi); } } while (0)
#define IDX_TILE(bc, tt) do { const int t_ = (tt); if (t_ < ntile) { const bool padkey = (t_ == nrt && n >= NMETA); \
            _Pragma("unroll") for (int mt = 0; mt < 4; ++mt) { const int qa = 2 * (4 * mh + mt); \
                f32x16 acc = {}; \
                _Pragma("unroll") for (int s = 0; s < 4; ++s) acc = __builtin_amdgcn_mfma_f32_32x32x16_bf16(af[mt][s], bc[s], acc, 0, 0, 0); \
                const f32x4 wa0 = *(const LAS f32x4*)(iwl + qa * 16 + 4 * hi), wa1 = *(const LAS f32x4*)(iwl + qa * 16 + 8 + 4 * hi); \
                const f32x4 wb0 = *(const LAS f32x4*)(iwl + (qa + 1) * 16 + 4 * hi), wb1 = *(const LAS f32x4*)(iwl + (qa + 1) * 16 + 8 + 4 * hi); \
                float p0 = 0.f, p1 = 0.f; \
                _Pragma("unroll") for (int r = 0; r < 4; ++r) { p0 += fmaxf(acc[r], 0.f) * wa0[r] + fmaxf(acc[4 + r], 0.f) * wa1[r]; p1 += fmaxf(acc[8 + r], 0.f) * wb0[r] + fmaxf(acc[12 + r], 0.f) * wb1[r]; } \
                const auto rr = __builtin_amdgcn_permlane32_swap(__float_as_uint(p0), __float_as_uint(p1), false, false); \
                float tot = __uint_as_float(rr[0]) + __uint_as_float(rr[1]); \
                if (padkey) tot = NINF; \
                scall[(qa + hi) * 2112 + 32 * t_ + n] = tot; } } } while (0)
        IDX_LOADB(b0, w); IDX_LOADB(b1, w + 8); IDX_LOADB(b2, w + 16);
        for (int t = w; t < ntile; t += 24) {
            IDX_TILE(b0, t);      IDX_LOADB(b0, t + 24);
            IDX_TILE(b1, t + 8);  IDX_LOADB(b1, t + 32);
            IDX_TILE(b2, t + 16); IDX_LOADB(b2, t + 40);
        }
#undef IDX_LOADB
#undef IDX_TILE
    }
    __syncthreads();
    LAS float* sc = scall + (2 * w + hi) * 2112;
    const int q0 = 16 * g + 2 * w;
    float v[66];
#pragma unroll
    for (int t = 0; t < 66; ++t) v[t] = NINF;
#pragma unroll
    for (int t = 0; t < 65; ++t) if (t <= nrt) v[t] = sc[32 * t + n];
    float thr = -3.0e38f;
    if (c >= 3) {
        float mn = __builtin_inff(), mx = NINF;
#pragma unroll
        for (int t = 0; t < 65; ++t) { mx = fmaxf(mx, v[t]); mn = fminf(mn, v[t] > NINF ? v[t] : mn); }
#pragma unroll
        for (int o = 1; o < 32; o <<= 1) { mn = fminf(mn, __shfl_xor(mn, o)); mx = fmaxf(mx, __shfl_xor(mx, o)); }
        float lo = mn, hh = mx; bool done = false; thr = mn;
        for (int it = 0; it < 64; ++it) {
            const float mid = 0.5f * lo + 0.5f * hh;
            if (!done && !(mid > lo && mid < hh)) { thr = lo; done = true; }
            if (__all(done)) break;
            int cnt = 0;
#pragma unroll
            for (int t = 0; t < 22; ++t) cnt += (v[t] >= mid) ? 1 : 0;
            if (nrt >= 22) {
#pragma unroll
                for (int t = 22; t < 44; ++t) cnt += (v[t] >= mid) ? 1 : 0; }
            if (nrt >= 44) {
#pragma unroll
                for (int t = 44; t < 65; ++t) cnt += (v[t] >= mid) ? 1 : 0; }
#pragma unroll
            for (int o = 1; o < 32; o <<= 1) cnt += __shfl_xor(cnt, o);
            if (!done) { if (cnt == 256) { thr = mid; done = true; } else if (cnt > 256) lo = mid; else hh = mid; }
        }
        if (!done) thr = lo;
    }
    unsigned w0 = 0u, w1 = 0u, w2 = 0u;
#pragma unroll
    for (int t = 0; t < 65; ++t) {
        const unsigned long long bal = __ballot(v[t] >= thr && v[t] > NINF);
        const unsigned mine = hi ? (unsigned)(bal >> 32) : (unsigned)bal;
        const bool ismeta = (t == nrt);
        if (t < 32) { if (!ismeta && n == t) w0 = mine; } else if (t < 64) { if (!ismeta && n == t - 32) w1 = mine; }
        if (ismeta && n == 0) w2 = mine;
    }
    unsigned* bm = BM + (size_t)(b * SEQ + q0 + hi) * 66;
    bm[n] = w0; bm[32 + n] = w1; if (n < 2) bm[64 + n] = w2;
}
__device__ __forceinline__ void idx_phase(Frame& F) {
    for (int u = blockIdx.x; u < NB * 128; u += F.G) { const int b = u >> 7, gr = u & 127, g = ((b >> 1) & 1) ? 127 - gr : gr;
        idx_unit(F, b, g); __syncthreads(); }
}

namespace att {
constexpr int SHM_V = 64 * 128 * 2, SHM_K = 64 * 128 * 2;
constexpr int OFF_V = 0, OFF_K = 2 * SHM_V, OFF_WS = OFF_K + 2 * SHM_K, OFF_BT = OFF_WS + NWAVES * 256, BTW = 384, BT_ZERO = 320;
#define KSWZ(row, colB) ((row) * 256 + ((colB) ^ (((row) & 7) << 4)))
__device__ __forceinline__ int v_st(int k, int c) { const int kk = (k & ~0xC) | ((k & 4) << 1) | ((k & 8) >> 1); return ((kk >> 3) * 4 + (c >> 5)) * 512 + ((kk & 7) * 32 + (c & 31)) * 2; }
__device__ __forceinline__ int v_rd_base(int lane) { return ((lane & 3) << 3) | (((lane >> 2) & 3) << 6) | (((lane >> 4) & 1) << 5) | (((lane >> 5) & 1) << 8); }
constexpr int v_rd_off(int d0, int ks, int half) { return d0 * 512 + ks * 4096 + half * 2048; }
template <int OFF> __device__ __forceinline__ s16x4 tr_read(int vb) { s16x4 r; asm volatile("ds_read_b64_tr_b16 %0, %1 offset:%2" : "=&v"(r) : "v"(vb), "i"(OFF) : "memory"); return r; }
template <int D0> __device__ __forceinline__ void pv_one(f32x16& od, int vb, bf16x8 pa0, bf16x8 pa1, bf16x8 pa2, bf16x8 pa3) {
    const s16x4 l0 = tr_read<v_rd_off(D0, 0, 0)>(vb), h0 = tr_read<v_rd_off(D0, 0, 1)>(vb), l1 = tr_read<v_rd_off(D0, 1, 0)>(vb), h1 = tr_read<v_rd_off(D0, 1, 1)>(vb);
    const s16x4 l2 = tr_read<v_rd_off(D0, 2, 0)>(vb), h2 = tr_read<v_rd_off(D0, 2, 1)>(vb), l3 = tr_read<v_rd_off(D0, 3, 0)>(vb), h3 = tr_read<v_rd_off(D0, 3, 1)>(vb);
    asm volatile("s_waitcnt lgkmcnt(0)" ::: "memory"); SBAR();
#define PK(L, H) (bf16x8){L[0], L[1], L[2], L[3], H[0], H[1], H[2], H[3]}
    od = __builtin_amdgcn_mfma_f32_32x32x16_bf16(pa0, PK(l0, h0), od, 0, 0, 0);
    od = __builtin_amdgcn_mfma_f32_32x32x16_bf16(pa1, PK(l1, h1), od, 0, 0, 0);
    od = __builtin_amdgcn_mfma_f32_32x32x16_bf16(pa2, PK(l2, h2), od, 0, 0, 0);
    od = __builtin_amdgcn_mfma_f32_32x32x16_bf16(pa3, PK(l3, h3), od, 0, 0, 0);
#undef PK
}
__device__ __forceinline__ void qkt(f32x16& p0, f32x16& p1, const LAS unsigned char* Ks, const bf16x8* qr, int r32, int hi) {
    p0 = f32x16{}; p1 = f32x16{};
#pragma unroll
    for (int d0 = 0; d0 < 8; ++d0) { const int cb = (d0 * 16 + hi * 8) * 2;
        const bf16x8 b0 = *(const LAS bf16x8*)(Ks + KSWZ(r32, cb));
        const bf16x8 b1 = *(const LAS bf16x8*)(Ks + KSWZ(32 + r32, cb));
        p0 = __builtin_amdgcn_mfma_f32_32x32x16_bf16(b0, qr[d0], p0, 0, 0, 0);
        p1 = __builtin_amdgcn_mfma_f32_32x32x16_bf16(b1, qr[d0], p1, 0, 0, 0); }
}
template <bool NEAR>
__device__ __forceinline__ void tile_sm(f32x16& p0, f32x16& p1, float& m_reg, float& l_reg, float& alpha, bf16x8& pa0, bf16x8& pa1, bf16x8& pa2, bf16x8& pa3,
                                        float cb, const LAS float* btl, unsigned mlo, unsigned mhi, int hi) {
    if (NEAR) {
#pragma unroll
        for (int r = 0; r < 16; ++r) { p0[r] += btl[(r & 3) + 8 * (r >> 2)]; p1[r] += btl[32 + (r & 3) + 8 * (r >> 2)]; }
    }
    float pmax = p0[0];
#pragma unroll
    for (int r = 1; r < 16; ++r) pmax = fmaxf(pmax, p0[r]);
#pragma unroll
    for (int r = 0; r < 16; ++r) pmax = fmaxf(pmax, p1[r]);
    { const auto rr = __builtin_amdgcn_permlane32_swap(__float_as_uint(pmax), __float_as_uint(pmax), false, false); pmax = fmaxf(__uint_as_float(rr[0]), __uint_as_float(rr[1])); }
    if (!NEAR) pmax += cb;
    const float mn = fmaxf(m_reg, pmax); alpha = __builtin_amdgcn_exp2f(m_reg - mn); m_reg = mn;
    const float off = (NEAR ? 0.f : cb) - mn;
    const unsigned w0 = mlo >> (4 * hi), w1 = mhi >> (4 * hi);
    float ps = 0.f;
#pragma unroll
    for (int r = 0; r < 16; ++r) { const int pos = (r & 3) + 8 * (r >> 2);
        const float e0 = __builtin_amdgcn_exp2f(p0[r] + off), e1 = __builtin_amdgcn_exp2f(p1[r] + off);
        p0[r] = __uint_as_float(__float_as_uint(e0) & (unsigned)__builtin_amdgcn_sbfe((int)w0, pos, 1));
        p1[r] = __uint_as_float(__float_as_uint(e1) & (unsigned)__builtin_amdgcn_sbfe((int)w1, pos, 1));
        ps += p0[r] + p1[r]; }
    { const auto rr = __builtin_amdgcn_permlane32_swap(__float_as_uint(ps), __float_as_uint(ps), false, false); ps = __uint_as_float(rr[0]) + __uint_as_float(rr[1]); }
    l_reg = l_reg * alpha + ps;
#define PK4(P, BASE, OUT) do { unsigned a0 = cvtpk(P[BASE + 0], P[BASE + 1]), a1 = cvtpk(P[BASE + 2], P[BASE + 3]);   \
    unsigned b0 = cvtpk(P[BASE + 4], P[BASE + 5]), b1 = cvtpk(P[BASE + 6], P[BASE + 7]);                              \
    auto r0 = __builtin_amdgcn_permlane32_swap(a0, b0, false, false); auto r1 = __builtin_amdgcn_permlane32_swap(a1, b1, false, false); \
    u32x4 w = {r0[0], r1[0], r0[1], r1[1]}; OUT = *reinterpret_cast<bf16x8*>(&w); } while (0)
    PK4(p0, 0, pa0); PK4(p0, 8, pa1); PK4(p1, 0, pa2); PK4(p1, 8, pa3);
#undef PK4
}
__device__ __forceinline__ void attn_unit(Frame& F, int b, int h, int qb) {
    const bf16_t* PROJ = (const bf16_t*)(F.ws + WS_PROJ); const bf16_t* KVP = (const bf16_t*)(F.ws + WS_KVP);
    const unsigned long long* BM = (const unsigned long long*)(F.ws + WS_BM);
    const float* BT = (const float*)(F.ws + WS_BT);
    bf16_t* YM = (bf16_t*)(F.ws + WS_YMIX);
    LAS unsigned char* lds = F.lds;
    const int tid = F.tid, wid = F.wave, lane = F.lane, r32 = lane & 31, hi = lane >> 5;
    LAS unsigned char* V_lds = lds + OFF_V; LAS unsigned char* K_lds = lds + OFF_K;
    LAS float* wsl = (LAS float*)(lds + OFF_WS) + wid * 64; LAS float* li_l = wsl; LAS float* al_l = wsl + 32;
    LAS float* btw = (LAS float*)(lds + OFF_BT) + wid * BTW;
    for (int i = lane; i < BTW; i += 64) btw[i] = BT[h * BT_N + (i - BT_ZERO + BT_OFF)];
    const int q0w = 256 * qb + 32 * wid, q = q0w + r32;
    const size_t tq = (size_t)(b * SEQ + q);
    const int nreal = 4 * (qb + 1), NT = nreal + 1;
    float m_reg = -1e30f, l_reg = 0.f; f32x16 o[4] = {}; bf16x8 qr[8];
    { const bf16_t* Qw = PROJ + tq * INP + C_AQ + h * 128 + hi * 8;
#pragma unroll
      for (int d0 = 0; d0 < 8; ++d0) qr[d0] = *(const bf16x8*)(Qw + d0 * 16); }
    const int sr = tid >> 4, sc = (tid & 15) * 8, vst0 = v_st(sr, sc), vst1 = v_st(32 + sr, sc);
    const int vb0 = (int)(unsigned)(size_t)V_lds + v_rd_base(lane);
    bf16x8 vs0, vs1, ks0, ks1;
    const bf16_t* Kh = KVP + h * 128 + sc; const bf16_t* Vh = KVP + 1024 + h * 128 + sc;
#define A_SLOAD(j) do { const size_t kb_ = (j) < nreal ? (size_t)(b * SEQ + 64 * (j)) : (size_t)T; \
    vs0 = *(const bf16x8*)(Vh + (kb_ + sr) * 2048); vs1 = *(const bf16x8*)(Vh + (kb_ + 32 + sr) * 2048); \
    ks0 = *(const bf16x8*)(Kh + (kb_ + sr) * 2048); ks1 = *(const bf16x8*)(Kh + (kb_ + 32 + sr) * 2048); } while (0)
#define A_SWRITE(bf) do { *(LAS bf16x8*)(V_lds + (bf) * SHM_V + vst0) = vs0; *(LAS bf16x8*)(V_lds + (bf) * SHM_V + vst1) = vs1; \
    *(LAS bf16x8*)(K_lds + (bf) * SHM_K + KSWZ(sr, sc * 2)) = ks0; *(LAS bf16x8*)(K_lds + (bf) * SHM_K + KSWZ(32 + sr, sc * 2)) = ks1; } while (0)
#define A_RESC(a) do { if (__any((a) < 1.f)) { if (hi == 0) al_l[r32] = (a); asm volatile("s_waitcnt lgkmcnt(0)" ::: "memory"); \
    _Pragma("unroll") for (int d = 0; d < 4; ++d) _Pragma("unroll") for (int r = 0; r < 16; ++r) o[d][r] *= al_l[crow(r, hi)]; } } while (0)
    const float cbfar = BT[h * BT_N + (-200 + BT_OFF)];
    A_SLOAD(0); unsigned long long mk = BM[tq * 33 + 0];
    VM_WAIT(); A_SWRITE(0); __syncthreads();
    for (int j = 0; j < NT; ++j) {
        const int cur = j & 1; const bool more = (j + 1 < NT);
        unsigned long long mkn = 0ull;
        if (more) { A_SLOAD(j + 1); mkn = BM[tq * 33 + ((j + 1) < nreal ? (j + 1) : 32)]; }
        f32x16 p0, p1; float alpha; bf16x8 pa0, pa1, pa2, pa3;
        qkt(p0, p1, K_lds + cur * SHM_K, qr, r32, hi);
        const bool meta = (j >= nreal);
        const bool nearT = meta ? (q0w < 96) : (64 * j + 63 - q0w > -91);
        if (nearT) { const int base = (meta ? (-16 - q) : (64 * j - q)) + BT_ZERO + 4 * hi;
            tile_sm<true>(p0, p1, m_reg, l_reg, alpha, pa0, pa1, pa2, pa3, 0.f, btw + base, (unsigned)mk, (unsigned)(mk >> 32), hi); }
        else tile_sm<false>(p0, p1, m_reg, l_reg, alpha, pa0, pa1, pa2, pa3, cbfar, btw, (unsigned)mk, (unsigned)(mk >> 32), hi);
        A_RESC(alpha);
        const int vb = vb0 + cur * SHM_V;
        pv_one<0>(o[0], vb, pa0, pa1, pa2, pa3); pv_one<1>(o[1], vb, pa0, pa1, pa2, pa3); pv_one<2>(o[2], vb, pa0, pa1, pa2, pa3); pv_one<3>(o[3], vb, pa0, pa1, pa2, pa3);
        if (more) { VM_WAIT(); A_SWRITE(cur ^ 1); }
        mk = mkn;
        __syncthreads();
    }
    if (hi == 0) li_l[r32] = l_reg; asm volatile("s_waitcnt lgkmcnt(0)" ::: "memory");
    float rli[16];
#pragma unroll
    for (int r = 0; r < 16; ++r) rli[r] = __builtin_amdgcn_rcpf(li_l[crow(r, hi)]);
    bf16_t* Ow = YM + (size_t)(b * SEQ + q0w) * DM + h * 128;
#pragma unroll
    for (int r = 0; r < 16; ++r) { const int orow = crow(r, hi);
#pragma unroll
        for (int d0 = 0; d0 < 4; ++d0) Ow[(size_t)orow * DM + d0 * 32 + r32] = f2bf(o[d0][r] * rli[r]); }
    __syncthreads();
#undef A_SLOAD
#undef A_SWRITE
#undef A_RESC
}
__device__ __forceinline__ void attn_phase(Frame& F) {
    for (int u = blockIdx.x; u < 512; u += F.G) { const int bh = (u >> 2) & 63, p = u & 3, qb = (u >= 256) ? 7 - p : p;
        attn_unit(F, bh >> 3, bh & 7, qb); }
}
#undef KSWZ
}

__device__ __forceinline__ size_t gla_row(int b, int c, int i) { return c == 0 ? (size_t)(T + i - 48) : (size_t)(b * SEQ + (c - 1) * 64 + i); }
__device__ __forceinline__ void gla_prep_unit(Frame& F, int b, int h, int c) {
    const bf16_t* PROJ = (const bf16_t*)(F.ws + WS_PROJ);
    bf16_t* QT = (bf16_t*)(F.ws + WS_QT); bf16_t* KTT = (bf16_t*)(F.ws + WS_KTT); bf16_t* VT = (bf16_t*)(F.ws + WS_VT); bf16_t* AT = (bf16_t*)(F.ws + WS_AT);
    float* EB = (float*)(F.ws + WS_EB);
    LAS unsigned char* lds = F.lds;
    LAS bf16_t* Qs = (LAS bf16_t*)lds;
    LAS bf16_t* Ks = (LAS bf16_t*)(lds + 64 * 136 * 2);
    LAS float* tot = (LAS float*)(lds + 2 * 64 * 136 * 2);
    LAS float* grs = tot + 512;
    const int tid = F.tid, d = tid & 127, ig = tid >> 7, G = b * NCH + c;
    u32x4 gl = {0u, 0u, 0u, 0u};
    if (tid < 128) { const int i = tid >> 1; if (c > 0 || i >= 48) gl = *(const u32x4*)(PROJ + gla_row(b, c, i) * INP + C_GR + 8 * (tid & 1)); }
    unsigned qk[16];
#pragma unroll
    for (int ii = 0; ii < 16; ++ii) { const int i = 16 * ig + ii; qk[ii] = 0u;
        if (c > 0 || i >= 48) { const size_t row = gla_row(b, c, i); qk[ii] = (unsigned)PROJ[row * INP + C_GQ + h * 128 + d] | ((unsigned)PROJ[row * INP + C_GK + h * 128 + d] << 16); } }
    unsigned vpk[16];
    { const int v = tid & 255, ih = tid >> 8;
#pragma unroll
      for (int j = 0; j < 16; ++j) { const int i0 = 32 * ih + 2 * j; unsigned lo = 0u, hi2 = 0u;
          if (c > 0 || i0 >= 48) lo = PROJ[gla_row(b, c, i0) * INP + C_GV + h * 256 + v];
          if (c > 0 || i0 + 1 >= 48) hi2 = PROJ[gla_row(b, c, i0 + 1) * INP + C_GV + h * 256 + v];
          vpk[j] = lo | (hi2 << 16); } }
    float wv[16];
#pragma unroll
    for (int r = 0; r < 16; ++r) wv[r] = F.in[I_WGK2][r * 512 + h * 128 + d];
    const float bg = F.in[I_BGK][h * 128 + d];
    if (tid < 128) { LAS float* gp = grs + (tid >> 1) * 16 + 8 * (tid & 1);
        gp[0] = bflo(gl.x); gp[1] = bfhi(gl.x); gp[2] = bflo(gl.y); gp[3] = bfhi(gl.y); gp[4] = bflo(gl.z); gp[5] = bfhi(gl.z); gp[6] = bflo(gl.w); gp[7] = bfhi(gl.w); }
    __syncthreads();
    float bl[16]; float run = 0.f;
#pragma unroll
    for (int ii = 0; ii < 16; ++ii) { const int i = 16 * ig + ii; const bool valid = (c > 0) || (i >= 48);
        const f32x4 a0 = *(const LAS f32x4*)(grs + i * 16), a1 = *(const LAS f32x4*)(grs + i * 16 + 4), a2 = *(const LAS f32x4*)(grs + i * 16 + 8), a3 = *(const LAS f32x4*)(grs + i * 16 + 12);
        float x = bg + a0.x * wv[0] + a0.y * wv[1] + a0.z * wv[2] + a0.w * wv[3] + a1.x * wv[4] + a1.y * wv[5] + a1.z * wv[6] + a1.w * wv[7]
                     + a2.x * wv[8] + a2.y * wv[9] + a2.z * wv[10] + a2.w * wv[11] + a3.x * wv[12] + a3.y * wv[13] + a3.z * wv[14] + a3.w * wv[15];
        const float gk = valid ? (fminf(x, 0.f) - __logf(1.f + __expf(-fabsf(x)))) * (1.f / 16.f) : 0.f;
        run += gk; bl[ii] = run; }
    tot[ig * 128 + d] = run;
    __syncthreads();
    float offs = 0.f, blast = 0.f;
#pragma unroll
    for (int gI = 0; gI < 4; ++gI) { const float tv = tot[gI * 128 + d]; blast += tv; if (gI < ig) offs += tv; }
#pragma unroll
    for (int ii = 0; ii < 16; ++ii) { const int i = 16 * ig + ii;
        const float bc = bl[ii] + offs;
        const bf16_t qt = f2bf(bflo(qk[ii]) * __expf(bc) * 0.08838834764831845f), kt = f2bf(bfhi(qk[ii]) * __expf(-bc));
        QT[((size_t)G * 64 + i) * 512 + h * 128 + d] = qt;
        Qs[i * 136 + d] = qt; Ks[i * 136 + d] = kt; }
    if (ig == 0) EB[(size_t)G * 512 + h * 128 + d] = __expf(blast);
    { const int v = tid & 255, ih = tid >> 8; u32x4* dst = (u32x4*)(VT + ((size_t)G * 1024 + h * 256 + v) * 64 + 32 * ih);
#pragma unroll
      for (int j = 0; j < 4; ++j) dst[j] = (u32x4){vpk[4 * j], vpk[4 * j + 1], vpk[4 * j + 2], vpk[4 * j + 3]}; }
    __syncthreads();
    { const int jg = ig; unsigned pk[8];
#pragma unroll
      for (int j = 0; j < 8; ++j) pk[j] = (unsigned)Ks[(16 * jg + 2 * j) * 136 + d] | ((unsigned)Ks[(16 * jg + 2 * j + 1) * 136 + d] << 16);
      u32x4* dst = (u32x4*)(KTT + (((size_t)G * 4 + h) * 128 + d) * 64 + 16 * jg);
      dst[0] = (u32x4){pk[0], pk[1], pk[2], pk[3]}; dst[1] = (u32x4){pk[4], pk[5], pk[6], pk[7]}; }
    if (F.wave < 4) { const int w = F.wave, ib = (w == 0 || w == 3) ? 0 : 1, jb = (w == 2 || w == 3) ? 1 : 0; const int n = F.lane & 31, hi = F.lane >> 5;
        f32x16 acc = {};
        if (w < 3) {
#pragma unroll
            for (int s = 0; s < 8; ++s) { const bf16x8 a = *(const LAS bf16x8*)(Qs + (32 * ib + n) * 136 + 16 * s + 8 * hi), bb = *(const LAS bf16x8*)(Ks + (32 * jb + n) * 136 + 16 * s + 8 * hi);
                acc = __builtin_amdgcn_mfma_f32_32x32x16_bf16(a, bb, acc, 0, 0, 0); } }
        bf16_t* dst = AT + (((size_t)G * 4 + h) * 64) * 64;
#pragma unroll
        for (int r = 0; r < 16; ++r) { const int i = 32 * ib + crow(r, hi), j = 32 * jb + n; dst[i * 64 + j] = f2bf(j <= i ? acc[r] : 0.f); } }
    __syncthreads();
}
__device__ __forceinline__ void gla_prep_phase(Frame& F) {
    for (int u = blockIdx.x; u < NB * NCH * 4; u += F.G) { const int h = u & 3, bc = u >> 2; gla_prep_unit(F, bc / NCH, h, bc % NCH); }
}
struct GlaOps { bf16x8 ka0, ka1, v00, v01, v10, v11; f32x4 eb; };
__device__ __forceinline__ void gla_load_ops(GlaOps& o, const bf16_t* KTT, const bf16_t* VT, const float* EB, int G, int h, int vs, int w, int l16, int q4) {
    const bf16_t* kt = KTT + (((size_t)G * 4 + h) * 128 + 16 * w + l16) * 64 + 8 * q4;
    const bf16_t* vt = VT + ((size_t)G * 1024 + h * 256 + 32 * vs + l16) * 64 + 8 * q4;
    o.ka0 = *(const bf16x8*)(kt); o.ka1 = *(const bf16x8*)(kt + 32);
    o.v00 = *(const bf16x8*)(vt); o.v01 = *(const bf16x8*)(vt + 32); o.v10 = *(const bf16x8*)(vt + 16 * 64); o.v11 = *(const bf16x8*)(vt + 16 * 64 + 32);
    o.eb = *(const f32x4*)(EB + (size_t)G * 512 + h * 128 + 16 * w + 4 * q4);
}
__device__ __forceinline__ void gla_scan_task(Frame& F, int b, int h, int vs, int w) {
    const bf16_t* KTT = (const bf16_t*)(F.ws + WS_KTT); const bf16_t* VT = (const bf16_t*)(F.ws + WS_VT); const float* EB = (const float*)(F.ws + WS_EB);
    bf16_t* SST = (bf16_t*)(F.ws + WS_SST);
    const int lane = F.lane, l16 = lane & 15, q4 = lane >> 4, G0 = b * NCH;
    f32x4 S0 = {0.f, 0.f, 0.f, 0.f}, S1 = {0.f, 0.f, 0.f, 0.f};
    for (int c0 = 0; c0 < NCH - 1; c0 += 6) {
        GlaOps o[6];
#pragma unroll
        for (int k = 0; k < 6; ++k) if (c0 + k < NCH - 1) gla_load_ops(o[k], KTT, VT, EB, G0 + c0 + k, h, vs, w, l16, q4);
        u32x2 r0[6], r1[6];
#pragma unroll
        for (int k = 0; k < 6; ++k) if (c0 + k < NCH - 1) {
            S0 = __builtin_amdgcn_mfma_f32_16x16x32_bf16(o[k].ka0, o[k].v00, S0, 0, 0, 0); S0 = __builtin_amdgcn_mfma_f32_16x16x32_bf16(o[k].ka1, o[k].v01, S0, 0, 0, 0);
            S1 = __builtin_amdgcn_mfma_f32_16x16x32_bf16(o[k].ka0, o[k].v10, S1, 0, 0, 0); S1 = __builtin_amdgcn_mfma_f32_16x16x32_bf16(o[k].ka1, o[k].v11, S1, 0, 0, 0);
            S0 = S0 * o[k].eb; S1 = S1 * o[k].eb;
            r0[k] = (u32x2){cvtpk(S0[0], S0[1]), cvtpk(S0[2], S0[3])}; r1[k] = (u32x2){cvtpk(S1[0], S1[1]), cvtpk(S1[2], S1[3])}; }
#pragma unroll
        for (int k = 0; k < 6; ++k) if (c0 + k < NCH - 1) {
            bf16_t* so = SST + (((size_t)(G0 + c0 + k) * 4 + h) * 256 + 32 * vs + l16) * 128 + 16 * w + 4 * q4;
            *(u32x2*)(so) = r0[k]; *(u32x2*)(so + 16 * 128) = r1[k]; }
    }
}
__device__ __forceinline__ void gla_scan_phase(Frame& F) {
    for (int u = F.gw; u < NB * 4 * 8 * 8; u += F.ngw) gla_scan_task(F, u >> 8, (u >> 6) & 3, (u >> 3) & 7, u & 7);
}
__device__ __forceinline__ void gla_out_unit(Frame& F, int b, int h, int c) {
    const bf16_t* PROJ = (const bf16_t*)(F.ws + WS_PROJ); const bf16_t* QT = (const bf16_t*)(F.ws + WS_QT); const bf16_t* AT = (const bf16_t*)(F.ws + WS_AT);
    const bf16_t* VT = (const bf16_t*)(F.ws + WS_VT); const bf16_t* SST = (const bf16_t*)(F.ws + WS_SST);
    bf16_t* YM = (bf16_t*)(F.ws + WS_YMIX);
    LAS float* part = (LAS float*)F.lds;
    const int w = F.wave, lane = F.lane, l16 = lane & 15, q4 = lane >> 4, G = b * NCH + c;
    bf16x8 sb[2][4], vb[2][2];
#pragma unroll
    for (int vh = 0; vh < 2; ++vh) { const bf16_t* sp = SST + (((size_t)(G - 1) * 4 + h) * 256 + 32 * w + 16 * vh + l16) * 128 + 8 * q4;
        const bf16_t* vp = VT + ((size_t)G * 1024 + h * 256 + 32 * w + 16 * vh + l16) * 64 + 8 * q4;
#pragma unroll
        for (int s2 = 0; s2 < 4; ++s2) sb[vh][s2] = *(const bf16x8*)(sp + 32 * s2);
        vb[vh][0] = *(const bf16x8*)(vp); vb[vh][1] = *(const bf16x8*)(vp + 32); }
    unsigned short xg[4][4][2];
#pragma unroll
    for (int it = 0; it < 4; ++it)
#pragma unroll
        for (int r = 0; r < 4; ++r) { const size_t trow = (size_t)(b * SEQ + (c - 1) * 64 + 16 * it + 4 * q4 + r);
            xg[it][r][0] = PROJ[trow * INP + C_GO + h * 256 + 32 * w + l16]; xg[it][r][1] = PROJ[trow * INP + C_GO + h * 256 + 32 * w + 16 + l16]; }
    f32x4 oa[4][2];
#pragma unroll
    for (int it = 0; it < 4; ++it) { const bf16_t* qp = QT + ((size_t)G * 64 + 16 * it + l16) * 512 + h * 128 + 8 * q4; const bf16_t* ap = AT + (((size_t)G * 4 + h) * 64 + 16 * it + l16) * 64 + 8 * q4;
        const bf16x8 q0 = *(const bf16x8*)(qp), q1 = *(const bf16x8*)(qp + 32), q2 = *(const bf16x8*)(qp + 64), q3 = *(const bf16x8*)(qp + 96), a0 = *(const bf16x8*)(ap), a1 = *(const bf16x8*)(ap + 32);
#pragma unroll
        for (int vh = 0; vh < 2; ++vh) { f32x4 a = {0.f, 0.f, 0.f, 0.f};
            a = __builtin_amdgcn_mfma_f32_16x16x32_bf16(q0, sb[vh][0], a, 0, 0, 0); a = __builtin_amdgcn_mfma_f32_16x16x32_bf16(q1, sb[vh][1], a, 0, 0, 0);
            a = __builtin_amdgcn_mfma_f32_16x16x32_bf16(q2, sb[vh][2], a, 0, 0, 0); a = __builtin_amdgcn_mfma_f32_16x16x32_bf16(q3, sb[vh][3], a, 0, 0, 0);
            a = __builtin_amdgcn_mfma_f32_16x16x32_bf16(a0, vb[vh][0], a, 0, 0, 0); a = __builtin_amdgcn_mfma_f32_16x16x32_bf16(a1, vb[vh][1], a, 0, 0, 0);
            oa[it][vh] = a; } }
#pragma unroll
    for (int it = 0; it < 4; ++it)
#pragma unroll
        for (int r = 0; r < 4; ++r) { float ss = oa[it][0][r] * oa[it][0][r] + oa[it][1][r] * oa[it][1][r];
            ss += __shfl_xor(ss, 1); ss += __shfl_xor(ss, 2); ss += __shfl_xor(ss, 4); ss += __shfl_xor(ss, 8);
            if (l16 == 0) part[(16 * it + 4 * q4 + r) * 8 + w] = ss; }
    __syncthreads();
    const float g0 = F.in[I_GNG][32 * w + l16], g1 = F.in[I_GNG][32 * w + 16 + l16];
#pragma unroll
    for (int it = 0; it < 4; ++it)
#pragma unroll
        for (int r = 0; r < 4; ++r) { const int i = 16 * it + 4 * q4 + r;
            const f32x4 p0 = *(const LAS f32x4*)(part + i * 8), p1 = *(const LAS f32x4*)(part + i * 8 + 4);
            const float rstd = 1.f / sqrtf(((p0.x + p0.y) + (p0.z + p0.w) + (p1.x + p1.y) + (p1.z + p1.w)) * (1.f / 256.f) + LN_EPS);
            const size_t trow = (size_t)(b * SEQ + (c - 1) * 64 + i);
            const float x0 = bf2f(xg[it][r][0]), x1 = bf2f(xg[it][r][1]);
            const float y0 = oa[it][0][r] * rstd * g0 * (x0 / (1.f + __expf(-x0))), y1 = oa[it][1][r] * rstd * g1 * (x1 / (1.f + __expf(-x1)));
            YM[trow * DM + 1024 + h * 256 + 32 * w + l16] = f2bf(y0); YM[trow * DM + 1024 + h * 256 + 32 * w + 16 + l16] = f2bf(y1); }
    __syncthreads();
}
__device__ __forceinline__ void gla_out_phase(Frame& F) {
    for (int u = blockIdx.x; u < NB * 4 * 32; u += F.G) gla_out_unit(F, u >> 7, (u >> 5) & 3, 1 + (u & 31));
}

__device__ __forceinline__ int f2key(float f) { const int b = __float_as_int(f); return b ^ ((b >> 31) & 0x7fffffff); }
__device__ __forceinline__ float key2f(int k) { return __int_as_float(k ^ ((k >> 31) & 0x7fffffff)); }
#define CEX(a, b) do { const int _t = max(a, b); b = min(a, b); a = _t; } while (0)
__device__ __forceinline__ void sort16_desc(int (&x)[16]) {
#pragma unroll
    for (int k = 2; k <= 16; k <<= 1)
#pragma unroll
        for (int j = k >> 1; j > 0; j >>= 1)
#pragma unroll
            for (int i = 0; i < 16; ++i) { const int l = i ^ j; if (l > i) { if ((i & k) == 0) CEX(x[i], x[l]); else CEX(x[l], x[i]); } }
}
__device__ __forceinline__ void merge16_desc(int (&a)[16], const int (&b)[16]) {
#pragma unroll
    for (int i = 0; i < 16; ++i) a[i] = max(a[i], b[15 - i]);
#pragma unroll
    for (int j = 8; j > 0; j >>= 1)
#pragma unroll
        for (int i = 0; i < 16; ++i) { const int l = i ^ j; if (l > i) CEX(a[i], a[l]); }
}
__device__ __forceinline__ void peer_topk_task(Frame& F, int t0, int h) {
    const bf16_t* QH = (const bf16_t*)(F.ws + WS_QH); const bf16_t* SKB = (const bf16_t*)(F.ws + WS_SKB);
    unsigned short* EIDX = (unsigned short*)(F.ws + WS_EIDX); float* GATE = (float*)(F.ws + WS_GATE);
    const int lane = F.lane, r32 = lane & 31, hi = lane >> 5;
    int L1[16], L2[16];
#pragma unroll
    for (int c = 0; c < 2; ++c) {
        f32x16 acc[4] = {};
        const bf16_t* qp = QH + (size_t)(t0 + r32) * DM + (h * 2 + c) * 128 + 8 * hi;
        const bf16_t* kp = SKB + ((size_t)(h * 2 + c) * 128 + r32) * 128 + 8 * hi;
#pragma unroll
        for (int s = 0; s < 8; ++s) { const bf16x8 bq = *(const bf16x8*)(qp + 16 * s);
#pragma unroll
            for (int nt = 0; nt < 4; ++nt) acc[nt] = __builtin_amdgcn_mfma_f32_32x32x16_bf16(*(const bf16x8*)(kp + (size_t)nt * 32 * 128 + 16 * s), bq, acc[nt], 0, 0, 0); }
        int L[16], M[16];
#pragma unroll
        for (int nt = 0; nt < 4; ++nt) {
#pragma unroll
            for (int r = 0; r < 16; ++r) { const int n = 32 * nt + (r & 3) + 8 * (r >> 2) + 4 * hi; M[r] = (f2key(acc[nt][r]) & ~127) | n; }
            sort16_desc(M);
            if (nt == 0) {
#pragma unroll
                for (int i = 0; i < 16; ++i) L[i] = M[i];
            } else merge16_desc(L, M);
        }
#pragma unroll
        for (int i = 0; i < 16; ++i) M[i] = __shfl_xor(L[i], 32);
        merge16_desc(L, M);
#pragma unroll
        for (int i = 0; i < 16; ++i) { if (c == 0) L1[i] = L[i]; else L2[i] = L[i]; }
    }
    int Lc[16], M[16]; int nm = 0;
#pragma unroll
    for (int j = 0; j < 16; ++j) { const float sm = key2f(L1[0] & ~127) + key2f(L2[j] & ~127); Lc[j] = (f2key(sm) & ~16383) | ((L1[0] & 127) << 7) | (L2[j] & 127); }
#pragma unroll
    for (int i = 1; i < 16; ++i)
#pragma unroll
        for (int j = 0; j < 16; ++j) if ((i + 1) * (j + 1) <= 16) { const float sm = key2f(L1[i] & ~127) + key2f(L2[j] & ~127);
            M[nm & 15] = (f2key(sm) & ~16383) | ((L1[i] & 127) << 7) | (L2[j] & 127); ++nm;
            if ((nm & 15) == 0) { sort16_desc(M); merge16_desc(Lc, M); } }
    { M[2] = M[3] = M[4] = M[5] = M[6] = M[7] = M[8] = M[9] = M[10] = M[11] = M[12] = M[13] = M[14] = M[15] = (int)0x80000000;
      if (M[0] < M[1]) { const int t_ = M[0]; M[0] = M[1]; M[1] = t_; }
      merge16_desc(Lc, M); }
    float ev[16]; float esum = 0.f; const float vmax = key2f(Lc[0] & ~16383);
#pragma unroll
    for (int k = 0; k < 16; ++k) { ev[k] = __expf(key2f(Lc[k] & ~16383) - vmax); esum += ev[k]; }
    const float rs = 1.f / esum;
    const size_t t = (size_t)(t0 + r32);
#pragma unroll
    for (int k = 0; k < 16; ++k) if ((k >> 3) == hi) { EIDX[t * 128 + h * 16 + k] = (unsigned short)(Lc[k] & 16383); GATE[t * 128 + h * 16 + k] = ev[k] * rs; }
}
__device__ __forceinline__ void peer_topk_phase(Frame& F) {
    for (int u = F.gw; u < (T / 32) * 8; u += F.ngw) peer_topk_task(F, (u >> 3) * 32, u & 7);
}

__device__ __forceinline__ void peer_scatter_phase(Frame& F) {
    const unsigned short* EIDX = (const unsigned short*)(F.ws + WS_EIDX); const float* GATE = (const float*)(F.ws + WS_GATE); float* GTOT = (float*)(F.ws + WS_GTOT);
    unsigned char* C8 = F.ws + WS_C; const int lane = F.lane;
    for (int r = F.gw; r < T; r += F.ngw) {
        unsigned char* crow = C8 + (size_t)r * NEXP;
#pragma unroll 8
        for (int j = 0; j < 16; ++j) ((u32x4*)crow)[j * 64 + lane] = (u32x4){0u, 0u, 0u, 0u};
        const size_t t = (size_t)r;
        const int e0 = EIDX[t * 128 + lane], e1 = EIDX[t * 128 + 64 + lane]; const float g0 = GATE[t * 128 + lane], g1 = GATE[t * 128 + 64 + lane];
        float tot0 = 0.f, tot1 = 0.f;
        for (int k = 0; k < 64; ++k) { const int ek = __builtin_amdgcn_readlane(e0, k); const float gk = __uint_as_float(__builtin_amdgcn_readlane(__float_as_uint(g0), k));
            tot0 += (e0 == ek) ? gk : 0.f; tot1 += (e1 == ek) ? gk : 0.f; }
        for (int k = 0; k < 64; ++k) { const int ek = __builtin_amdgcn_readlane(e1, k); const float gk = __uint_as_float(__builtin_amdgcn_readlane(__float_as_uint(g1), k));
            tot0 += (e0 == ek) ? gk : 0.f; tot1 += (e1 == ek) ? gk : 0.f; }
        GTOT[t * 128 + lane] = tot0; GTOT[t * 128 + 64 + lane] = tot1;
        VM_WAIT();
        crow[e0] = (unsigned char)(1 + lane); crow[e1] = (unsigned char)(65 + lane);
    }
}

struct Args { const float* in[20]; float* out; unsigned char* ws; int ph_lo, ph_hi; };
constexpr int N_PHASES = 16;
__global__ void __launch_bounds__(NTHREADS, 2) mk_fwd(Args args) {
    extern __shared__ __attribute__((aligned(16))) unsigned char lds_raw[];
    Frame F;
    F.lds = (LAS unsigned char*)lds_raw;
    F.tid = threadIdx.x; F.lane = F.tid & 63; F.wave = __builtin_amdgcn_readfirstlane(F.tid >> 6);
    F.G = gridDim.x; F.gw = blockIdx.x * NWAVES + F.wave; F.ngw = F.G * NWAVES;
#pragma unroll
    for (int i = 0; i < 20; ++i) F.in[i] = args.in[i];
    F.out = args.out; F.ws = args.ws;
    volatile LAS unsigned* lctl = (volatile LAS unsigned*)(F.lds + LDSCTL_OFF);
    if (F.tid < 64) lctl[F.tid] = 0u;
    __syncthreads();
    unsigned* ctl = (unsigned*)(F.ws + WS_CTL);
    const int lo = args.ph_lo, hi = args.ph_hi;
    XcdBarrier bar; bar.bar = ctl + 1024; bar.x = 0; bar.st = lctl + 8;
    if (hi - lo > 1) bar = xcd_barrier_post(ctl + 1024, lctl + 8);
#define IN(k) (lo <= (k) && (k) < hi)
#define SEAM(k) do { if (IN(k) && IN((k) + 1)) xcd_barrier(bar); } while (0)
#define LOCAL(k) do { if (IN(k) && IN((k) + 1)) __syncthreads(); } while (0)
    const int bid = blockIdx.x;
#define REFRESH() do { int t_ = threadIdx.x; asm volatile("" : "+v"(t_)); F.tid = t_; F.lane = t_ & 63; } while (0)

    if (IN(0)) { REFRESH(); p0_prologue(F); } SEAM(0);
    if (IN(1)) { REFRESH();
        pg8::Gemm g{(const bf16_t*)(F.ws + WS_H0), (const bf16_t*)(F.ws + WS_WIN), TM, INP, DM, DM, DM}; pg8::StaticOrder S; S.init(TM, INP, F.G, bid);
        pg8::EpiBf16 E{(bf16_t*)(F.ws + WS_PROJ), INP, 1.f};
        pg8::gemm_phase<pg8::EpiBf16, true>(F.lds, g, S, E);
    } SEAM(1);
    if (IN(2)) { REFRESH();
        kv_meta(F);
        pg8::Gemm g{(const bf16_t*)(F.ws + WS_PROJ) + C_CKV, (const bf16_t*)(F.ws + WS_WKV), T, 2048, 256, INP, 256}; pg8::StaticOrder S; S.init(T, 2048, F.G, bid);
        pg8::EpiBf16 E{(bf16_t*)(F.ws + WS_KVP), 2048, 1.f};
        pg8::gemm_phase<pg8::EpiBf16, true>(F.lds, g, S, E);
    } LOCAL(2);
    if (IN(3)) { REFRESH(); idx_phase(F); } LOCAL(3);
    if (IN(4)) { REFRESH(); gla_prep_phase(F); } SEAM(4);
    if (IN(5)) { REFRESH(); gla_scan_phase(F); } LOCAL(5);
    if (IN(6)) { REFRESH(); att::attn_phase(F); } SEAM(6);
    if (IN(7)) { REFRESH(); gla_out_phase(F); } SEAM(7);
    if (IN(8)) { REFRESH();
        pg8::Gemm g{(const bf16_t*)(F.ws + WS_YMIX), (const bf16_t*)(F.ws + WS_WO), T, DM, DM, DM, DM}; pg8::StaticOrder S; S.init(T, DM, F.G, bid);
        pg8::EpiResLn0 E{F.out, DM, F.in[I_X], (const float*)(F.ws + WS_ST0), F.in[I_LN0G], F.in[I_LN0B], ALPHA};
        pg8::gemm_phase<pg8::EpiResLn0, true>(F.lds, g, S, E);
    } SEAM(8);
    if (IN(9)) { REFRESH();
        bf16_t* H1 = (bf16_t*)(F.ws + WS_H1); unsigned* H1F8 = (unsigned*)(F.ws + WS_H1F8);
        for (int m = F.gw; m < T; m += F.ngw) ln_row_to_bf16(F.out + (size_t)m * DM, F.in[I_LN1G], F.in[I_LN1B], H1 + (size_t)m * DM, F.lane, H1F8 + (size_t)m * (DM / 4));
        convert_f32_f8(F.in[I_UTAB], F.ws + WS_UF8, pg8::PEER_SU, (size_t)NEXP * DM / 8, (size_t)F.gw * 64 + F.lane, (size_t)F.ngw * 64);
        { LAS float* scr = (LAS float*)(F.lds + F.wave * 8704);
          for (int it = F.gw; it < (NEXP / 64) * (DM / 32); it += F.ngw) transpose_item_f8(F.in[I_VTAB], DM, F.ws + WS_VF8, NEXP, pg8::PEER_SV, scr, it, F.lane); }
    } SEAM(9);
    if (IN(10)) { REFRESH();
        pg8::Gemm g{(const bf16_t*)(F.ws + WS_H1), (const bf16_t*)(F.ws + WS_WPQ), T, DM, DM, DM, DM}; pg8::StaticOrder S; S.init(T, DM, F.G, bid);
        pg8::EpiBf16 E{(bf16_t*)(F.ws + WS_QH), DM, 1.f};
        pg8::gemm_phase<pg8::EpiBf16, true>(F.lds, g, S, E);
    } SEAM(10);
    if (IN(11)) { REFRESH(); peer_topk_phase(F); } SEAM(11);
    if (IN(12)) { REFRESH(); peer_scatter_phase(F); } SEAM(12);
    if (IN(13)) { REFRESH();
        pg8::Gemm g{(const bf16_t*)(F.ws + WS_H1F8), (const bf16_t*)(F.ws + WS_UF8), T, NEXP, DM / 2, DM / 2, DM / 2}; pg8::StaticOrder S; S.init(T, NEXP, F.G, bid);
        pg8::EpiPeer E{F.ws + WS_C, NEXP, (const float*)(F.ws + WS_GTOT), 1.f / pg8::PEER_SU};
        pg8::gemm_phase<pg8::EpiPeer, true, true>(F.lds, g, S, E);
    } SEAM(13);
    if (IN(14)) { REFRESH();
        pg8::Gemm g{(const bf16_t*)(F.ws + WS_C), (const bf16_t*)(F.ws + WS_VF8), T, DM, NEXP / 2, NEXP / 2, NEXP / 2}; pg8::StaticOrder S; S.init(T, DM, F.G, bid);
        pg8::EpiResF32 E{F.out, DM, (const bf16_t*)(F.ws + WS_H1), DM, ALPHA, 1.f / (pg8::PEER_SC * pg8::PEER_SV)};
        pg8::gemm_phase<pg8::EpiResF32, true, true>(F.lds, g, S, E);
    } SEAM(14);
    if (IN(15)) { REFRESH(); for (int m = F.gw; m < T; m += F.ngw) ln_row_to_f32(F.out + (size_t)m * DM, F.in[I_LN2G], F.in[I_LN2B], F.out + (size_t)m * DM, F.lane); }
#undef LOCAL
#undef REFRESH
#undef IN
#undef SEAM
}

#ifndef MK_REPS
#define MK_REPS {1,1,1,1,1,1,1,1,1,1,1,1,1,1,1,1}
#endif
#ifndef MK_ONE_LAUNCH
#define MK_ONE_LAUNCH 1
#endif
extern "C" void kernel_launch(void* const* d_in, const int* in_sizes, int n_in, void* d_out, int out_size, void* d_ws, size_t ws_size, hipStream_t stream) {
    static int grid = 0;
    if (grid == 0) {
        if (n_in != 20 || out_size != T * DM || ws_size < WS_END) { fprintf(stderr, "kernel_launch: shape mismatch n_in %d out %d ws %zu (need %zu)\n", n_in, out_size, ws_size, (size_t)WS_END); grid = -1; return; }
        int dev = 0, cus = 0, per_cu = 0;
        if (hipGetDevice(&dev) != hipSuccess || hipDeviceGetAttribute(&cus, hipDeviceAttributeMultiprocessorCount, dev) != hipSuccess) { grid = -1; return; }
        if (hipFuncSetAttribute((const void*)mk_fwd, hipFuncAttributeMaxDynamicSharedMemorySize, LDS_BYTES) != hipSuccess) { fprintf(stderr, "kernel_launch: hipFuncSetAttribute failed\n"); grid = -1; return; }
        if (hipOccupancyMaxActiveBlocksPerMultiprocessor(&per_cu, (const void*)mk_fwd, NTHREADS, LDS_BYTES) != hipSuccess || per_cu < 1) fprintf(stderr, "kernel_launch: occupancy query says %d\n", per_cu);
        (void)hipGetLastError();
        grid = cus;
    }
    if (grid < 0) return;
    (void)hipMemsetAsync((char*)d_ws + WS_CTL, 0, CTL_ZERO_BYTES, stream);
    Args a{};
    for (int i = 0; i < 20; ++i) a.in[i] = (const float*)d_in[i];
    a.out = (float*)d_out; a.ws = (unsigned char*)d_ws;
#if MK_ONE_LAUNCH
    a.ph_lo = 0; a.ph_hi = N_PHASES;
    hipLaunchKernelGGL(mk_fwd, dim3(grid), dim3(NTHREADS), LDS_BYTES, stream, a);
#else
    static const int reps[N_PHASES] = MK_REPS;
    for (int p = 0; p < N_PHASES; ++p) for (int r = 0; r < reps[p]; ++r) { a.ph_lo = p; a.ph_hi = p + 1; hipLaunchKernelGGL(mk_fwd, dim3(grid), dim3(NTHREADS), LDS_BYTES, stream, a); }
#endif
}
```

```cpp
#include <hip/hip_runtime.h>
#include <cstdio>
#include <cstdint>

#define LAS __attribute__((address_space(3)))
#define GAS __attribute__((address_space(1)))
typedef unsigned short bf16_t;
typedef short bf16x8 __attribute__((ext_vector_type(8)));
typedef short s16x4 __attribute__((ext_vector_type(4)));
typedef float f32x2 __attribute__((ext_vector_type(2)));
typedef float f32x4 __attribute__((ext_vector_type(4)));
typedef float f32x16 __attribute__((ext_vector_type(16)));
typedef unsigned u32x2 __attribute__((ext_vector_type(2)));
typedef unsigned u32x4 __attribute__((ext_vector_type(4)));

constexpr int DM = 2048, NB = 8, SEQ = 2048, NMETA = 16, T = NB * SEQ, TM = T + 256;
constexpr int INC = 5472, INP = 5632;
constexpr int C_AQ = 0, C_CKV = 1024, C_IQ = 1280, C_IK = 2304, C_IW = 2368, C_GQ = 2384, C_GK = 2896, C_GV = 3408, C_GR = 4432, C_GO = 4448;
constexpr int NEXP = 16384;
constexpr float LN_EPS = 1e-5f, ALPHA = 1.189207115002721f, LOG2E = 1.4426950408889634f;
constexpr int NCH = 33;
constexpr int PCH = 8192;

constexpr size_t MiB = 1u << 20;
constexpr size_t WS_CTL = 0, CTL_ZERO_BYTES = 64 * 1024;
constexpr size_t WS_BT = 64 * 1024;
constexpr size_t WS_SKB = 256 * 1024;
constexpr size_t WS_WKV = 1 * MiB;
constexpr size_t WS_EB = 2 * MiB;
constexpr size_t WS_GSS = 3 * MiB;
constexpr size_t WS_H0 = 8 * MiB;
constexpr size_t WS_WIN = 73 * MiB;
constexpr size_t WS_SST = 8 * MiB;
constexpr size_t WS_QT = 74 * MiB;
constexpr size_t WS_AT = 90 * MiB + 512 * 1024;
constexpr size_t WS_ST0 = 7 * MiB;
constexpr size_t WS_PROJ = 99 * MiB;
constexpr size_t WS_KVP = 278 * MiB;
constexpr size_t WS_BM = 343 * MiB;
constexpr size_t WS_KTT = 348 * MiB;
constexpr size_t WS_VT = 365 * MiB;
constexpr size_t WS_GLAO = 398 * MiB;
constexpr size_t WS_YMIX = 430 * MiB;
constexpr size_t WS_WPQ = 496 * MiB;
constexpr size_t WS_WO = 504 * MiB;
constexpr size_t WS_H1 = 8 * MiB;
constexpr size_t WS_UF8 = 72 * MiB;
constexpr size_t WS_VF8 = 104 * MiB;
constexpr size_t WS_H1F8 = 136 * MiB;
constexpr size_t WS_EIDX = 200 * MiB;
constexpr size_t WS_GATE = 204 * MiB;
constexpr size_t WS_PBM = 212 * MiB;
constexpr size_t WS_C = 244 * MiB;
constexpr size_t WS_QH = 244 * MiB;
constexpr size_t WS_END = 512 * MiB;
static_assert(WS_C + (size_t)T * NEXP <= WS_WO, "C vs WoT");

constexpr int RING_BYTES = 135168;
constexpr int LDSCTL_OFF = 139264;
constexpr int LDS_BYTES = 147456;
constexpr int NWAVES = 8, NTHREADS = 512;

#define LDS_WAIT() asm volatile("s_waitcnt lgkmcnt(0)" ::: "memory")
#define VM_WAIT() asm volatile("s_waitcnt vmcnt(0)" ::: "memory")
#define SBAR() __builtin_amdgcn_sched_barrier(0)

typedef __bf16 bf16x2_t __attribute__((ext_vector_type(2)));
__device__ __forceinline__ unsigned cvtpk(float lo, float hi) { const f32x2 v = {lo, hi}; return __builtin_bit_cast(unsigned, __builtin_convertvector(v, bf16x2_t)); }
__device__ __forceinline__ bf16_t f2bf(float f) { return (bf16_t)(cvtpk(f, 0.f) & 0xffffu); }
__device__ __forceinline__ float bf2f(unsigned short b) { return __uint_as_float(((unsigned)b) << 16); }
__device__ __forceinline__ float bflo(unsigned w) { return __uint_as_float(w << 16); }
__device__ __forceinline__ float bfhi(unsigned w) { return __uint_as_float(w & 0xffff0000u); }
__device__ __forceinline__ float wave_sum(float v) {
#pragma unroll
    for (int o = 1; o < 64; o <<= 1) v += __shfl_xor(v, o);
    return v;
}
__device__ __forceinline__ int crow(int r, int hi) { return (r & 3) + 8 * (r >> 2) + 4 * hi; }

#define XB_TMO      128
#define XB_XCNT(j)  (256  + 64 * (j))
#define XB_XSUB(j)  (1280 + 64 * (j))
#define XB_XGEN(j)  (2304 + 64 * (j))
#define XB_TOP      3328
#define XB_TOPGEN   3392
#define XCD_BAR_WORDS 3456
#define XB_SPIN_CAP (1u << 18)
__device__ __forceinline__ unsigned xb_ld(unsigned* p)              { return __hip_atomic_load(p, __ATOMIC_RELAXED, __HIP_MEMORY_SCOPE_AGENT); }
__device__ __forceinline__ unsigned xb_add(unsigned* p, unsigned v) { return __hip_atomic_fetch_add(p, v, __ATOMIC_RELAXED, __HIP_MEMORY_SCOPE_AGENT); }
__device__ __forceinline__ unsigned xb_xcc_id() { return (unsigned)__builtin_amdgcn_s_getreg((3 << 11) | 20) & 0xFu; }
#define XB_SPIN(cond, bar) do { unsigned _sp = 0; while (cond) { __builtin_amdgcn_s_sleep(1); \
    if ((++_sp & 255u) == 0u) { if (xb_ld(&(bar)[XB_TMO])) break; if (_sp > XB_SPIN_CAP) { atomicAdd(&(bar)[XB_TMO], 1u); break; } } } } while (0)
struct XcdBarrier { unsigned* bar; unsigned x; volatile LAS unsigned* st; };
__device__ __forceinline__ XcdBarrier xcd_barrier_post(unsigned* bar, volatile LAS unsigned* st) {
    XcdBarrier b; b.bar = bar; b.x = xb_xcc_id(); b.st = st;
    if (threadIdx.x == 0) (void)xb_add(&bar[XB_XCNT(b.x)], 1u);
    return b;
}
__device__ __forceinline__ void xcd_barrier_complete(unsigned* bar, unsigned x, unsigned& nloc, unsigned& nx) {
    const unsigned G = gridDim.x * gridDim.y * gridDim.z;
    unsigned sum, cnt, mine, sp = 0u;
    for (;;) {
        sum = 0u; cnt = 0u; mine = 0u;
#pragma unroll
        for (unsigned j = 0; j < 16; ++j) { const unsigned c = xb_ld(&bar[XB_XCNT(j)]); sum += c; cnt += (c > 0u) ? 1u : 0u; mine = (j == x) ? c : mine; }
        if (sum == G) break;
        __builtin_amdgcn_s_sleep(1);
        if ((++sp & 255u) == 0u) { if (xb_ld(&bar[XB_TMO])) break; if (sp > XB_SPIN_CAP) { atomicAdd(&bar[XB_TMO], 1u); break; } }
    }
    nloc = mine > 0u ? mine : 1u; nx = cnt > 0u ? cnt : 1u;
}
__device__ __forceinline__ void xcd_barrier(const XcdBarrier& b) {
    asm volatile("s_waitcnt vmcnt(0)" ::: "memory");
    __syncthreads();
    if (threadIdx.x == 0) {
        unsigned* bar = b.bar;
        __builtin_amdgcn_s_waitcnt(0);
        unsigned nloc = b.st[0], nx = b.st[1];
        if (nloc == 0u) { xcd_barrier_complete(bar, b.x, nloc, nx); b.st[0] = nloc; b.st[1] = nx; }
        const unsigned old = xb_add(&bar[XB_XSUB(b.x)], 1u);
        const unsigned gen = old / nloc;
        if (old + 1u == (gen + 1u) * nloc) {
            __builtin_amdgcn_fence(__ATOMIC_RELEASE, "agent");
            asm volatile("s_waitcnt vmcnt(0)" ::: "memory");
            const unsigned og = xb_add(&bar[XB_TOP], 1u);
            const unsigned tg = og / nx;
            if (og + 1u == (tg + 1u) * nx) xb_add(&bar[XB_TOPGEN], 1u);
            else XB_SPIN(xb_ld(&bar[XB_TOPGEN]) == tg, bar);
            __builtin_amdgcn_fence(__ATOMIC_ACQUIRE, "agent");
            xb_add(&bar[XB_XGEN(b.x)], 1u);
            asm volatile("s_waitcnt vmcnt(0)" ::: "memory");
        } else {
            XB_SPIN(xb_ld(&bar[XB_XGEN(b.x)]) == gen, bar);
            __builtin_amdgcn_fence(__ATOMIC_ACQUIRE, "agent");
            asm volatile("s_waitcnt vmcnt(0)" ::: "memory");
        }
    }
    __syncthreads();
}

namespace pg8 {
constexpr int BM = 256, BK = 64, HALF = 128, HTB = HALF * BK * 2, STAGE_BYTES = 8 * HTB, NXCD = 8, WGM = 8;
__host__ __device__ __forceinline__ int lds_byte(int r, int c) { const int st = (r >> 4) * 2 + (c >> 5), rr = r & 15, cc = c & 31, ob = rr * 64 + cc * 2; return st * 1024 + (ob ^ (((ob >> 9) & 1) << 5)); }
__host__ __device__ __forceinline__ void stage_rc(int b, int& R, int& C) { const int st = b / 1024, sb = b % 1024, swz = sb ^ (((sb >> 9) & 1) << 5); R = (st >> 1) * 16 + swz / 64; C = (st & 1) * 32 + (swz % 64) / 2; }
__host__ __device__ __forceinline__ int perm32(int rho) { const int n = rho >> 4, i = rho & 15; return 8 * (i >> 2) + 4 * n + (i & 3); }
struct Unit { int pm, pn; };
struct Gemm { const bf16_t* A; const bf16_t* Bt; int M, N, K, lda, ldb; };
struct StaticOrder {
    int nM, nN, nwg, G, c;
    __host__ __device__ void init(int M, int N, int G_, int c_) { nM = M / BM; nN = N / BM; nwg = nM * nN; G = G_; c = c_; }
    __host__ __device__ bool next(int i, Unit& u) const {
        const long L = (long)i * G + c; if (L >= nwg) return false;
        int wgid = (int)L; { const int q = nwg / NXCD, r = nwg % NXCD, xcd = wgid % NXCD, off = wgid / NXCD; wgid = (xcd < r ? xcd * (q + 1) : r * (q + 1) + (xcd - r) * q) + off; }
        const int nig = WGM * nN, gid = wgid / nig, fm = gid * WGM, gsz = (nM - fm) < WGM ? (nM - fm) : WGM;
        u.pm = fm + ((wgid % nig) % gsz); u.pn = (wgid % nig) / gsz; return true;
    }
};
struct EpiBf16 {
    static constexpr bool PERM = true;
    bf16_t* O; int ldc; float sc;
    __device__ __forceinline__ void operator()(const f32x4 (&acc)[2][2][4][2], const Unit& u, int wr, int wc, int fr, int fq) const {
        const int row0 = u.pm * BM + wr * 64 + fr, col0 = u.pn * BM + wc * 32 + 8 * fq;
#pragma unroll
        for (int ai = 0; ai < 2; ++ai)
#pragma unroll
            for (int m = 0; m < 4; ++m) { bf16_t* rowp = O + (size_t)(row0 + ai * HALF + m * 16) * ldc + col0;
#pragma unroll
                for (int bj = 0; bj < 2; ++bj) { const f32x4 v0 = acc[ai][bj][m][0] * sc, v1 = acc[ai][bj][m][1] * sc;
                    u32x4 w; w.x = cvtpk(v0[0], v0[1]); w.y = cvtpk(v0[2], v0[3]); w.z = cvtpk(v1[0], v1[1]); w.w = cvtpk(v1[2], v1[3]);
                    *(u32x4*)(rowp + bj * HALF) = w; } }
    }
};
struct EpiResF32 {
    static constexpr bool PERM = false;
    float* out; int ldc; const bf16_t* base; int ldbase; float alpha; float sc;
    __device__ __forceinline__ void operator()(const f32x4 (&acc)[2][2][4][2], const Unit& u, int wr, int wc, int fr, int fq) const {
        const int row0 = u.pm * BM + wr * 64 + fr, col0 = u.pn * BM + wc * 32 + 4 * fq;
#pragma unroll
        for (int ai = 0; ai < 2; ++ai)
#pragma unroll
            for (int m = 0; m < 4; ++m) { const size_t row = (size_t)(row0 + ai * HALF + m * 16);
#pragma unroll
                for (int bj = 0; bj < 2; ++bj)
#pragma unroll
                    for (int n = 0; n < 2; ++n) { const int c = col0 + bj * HALF + n * 16;
                        const u32x2 bw = *(const u32x2*)(base + row * ldbase + c);
                        f32x4 o = acc[ai][bj][m][n] * sc;
                        o[0] += alpha * bflo(bw.x); o[1] += alpha * bfhi(bw.x); o[2] += alpha * bflo(bw.y); o[3] += alpha * bfhi(bw.y);
                        *(f32x4*)(out + row * ldc + c) = o; } }
    }
};
struct EpiResLn0 {
    static constexpr bool PERM = false;
    float* out; int ldc; const float* x; const float* st; const float* g; const float* b; float alpha;
    __device__ __forceinline__ void operator()(const f32x4 (&acc)[2][2][4][2], const Unit& u, int wr, int wc, int fr, int fq) const {
        const int row0 = u.pm * BM + wr * 64 + fr, col0 = u.pn * BM + wc * 32 + 4 * fq;
        f32x4 gg[2][2], bb[2][2];
#pragma unroll
        for (int bj = 0; bj < 2; ++bj)
#pragma unroll
            for (int n = 0; n < 2; ++n) { gg[bj][n] = *(const f32x4*)(g + col0 + bj * HALF + n * 16) * alpha; bb[bj][n] = *(const f32x4*)(b + col0 + bj * HALF + n * 16) * alpha; }
#pragma unroll
        for (int ai = 0; ai < 2; ++ai)
#pragma unroll
            for (int m = 0; m < 4; ++m) { const size_t row = (size_t)(row0 + ai * HALF + m * 16); const f32x2 ms = *(const f32x2*)(st + 2 * row);
#pragma unroll
                for (int bj = 0; bj < 2; ++bj)
#pragma unroll
                    for (int n = 0; n < 2; ++n) { const int c = col0 + bj * HALF + n * 16;
                        const f32x4 xv = *(const f32x4*)(x + row * ldc + c);
                        *(f32x4*)(out + row * ldc + c) = acc[ai][bj][m][n] + ((xv - ms.x) * ms.y) * gg[bj][n] + bb[bj][n]; } }
    }
};
__device__ __forceinline__ float gelu_exact(float v) {
    const float av = fabsf(v), t = __builtin_amdgcn_rcpf(av * 0.2316418882f + 1.0f);
    float q = t * 0.5307027145f + (-0.7265760135f); q = q * t + 0.7107068705f; q = q * t + (-0.142248368f); q = q * t + 0.127414796f; q = q * t;
    const float e = __builtin_amdgcn_exp2f((v * v) * (-0.72134752044f));
    const float m = v * (q * e);
    return v < 0.f ? m : v - m;
}
constexpr float PEER_SU = 64.f, PEER_SV = 8.f, PEER_SC = 64.f;
struct EpiPeer {
    static constexpr bool PERM = true;
    unsigned char* O; int ldc; const unsigned char* pbm; float su_inv;
    __device__ __forceinline__ void operator()(const f32x4 (&acc)[2][2][4][2], const Unit& u, int wr, int wc, int fr, int fq) const {
        const int row0 = u.pm * BM + wr * 64 + fr, col0 = u.pn * BM + wc * 32 + 8 * fq;
#pragma unroll
        for (int ai = 0; ai < 2; ++ai) {
            u32x2 gw[4][2]; unsigned bits[4][2];
#pragma unroll
            for (int m = 0; m < 4; ++m)
#pragma unroll
                for (int bj = 0; bj < 2; ++bj) { const size_t row = (size_t)(row0 + ai * HALF + m * 16);
                    gw[m][bj] = *(const u32x2*)(O + row * ldc + col0 + bj * HALF); bits[m][bj] = pbm[row * 2048 + ((col0 + bj * HALF) >> 3)]; }
#pragma unroll
            for (int m = 0; m < 4; ++m)
#pragma unroll
                for (int bj = 0; bj < 2; ++bj) { const size_t row = (size_t)(row0 + ai * HALF + m * 16);
                    unsigned o0 = 0u, o1 = 0u; unsigned bt = bits[m][bj];
                    if (bt) { const f32x4 v0 = acc[ai][bj][m][0], v1 = acc[ai][bj][m][1]; const u32x2 g = gw[m][bj];
                        while (bt) { const int j = __builtin_ctz(bt); bt &= bt - 1u;
                            const unsigned gb = ((j < 4 ? g.x : g.y) >> (8 * (j & 3))) & 255u;
                            float x = v0[0]; x = (j == 1) ? v0[1] : x; x = (j == 2) ? v0[2] : x; x = (j == 3) ? v0[3] : x; x = (j == 4) ? v1[0] : x; x = (j == 5) ? v1[1] : x; x = (j == 6) ? v1[2] : x; x = (j == 7) ? v1[3] : x;
                            const float val = __builtin_amdgcn_cvt_f32_fp8((int)gb, 0) * (PEER_SC / 256.f) * gelu_exact(x * su_inv);
                            const unsigned ob = (unsigned)__builtin_amdgcn_cvt_pk_fp8_f32(val, 0.f, 0, false) & 255u;
                            if (j < 4) o0 |= ob << (8 * j); else o1 |= ob << (8 * (j - 4)); } }
                    *(u32x2*)(O + row * ldc + col0 + bj * HALF) = (u32x2){o0, o1}; }
        }
    }
};

typedef int v8i_t __attribute__((ext_vector_type(8)));
typedef int v4i_t __attribute__((ext_vector_type(4)));
template <class Epi, bool ALIGN_EPI, bool F8 = false>
__device__ __forceinline__ void gemm_phase(LAS unsigned char* lds, const Gemm g, const StaticOrder& S, const Epi& E) {
    const int tid = threadIdx.x, wid = __builtin_amdgcn_readfirstlane(tid >> 6), lane = tid & 63, wr = wid >> 2, wc = wid & 3, fr = lane & 15, fq = lane >> 4;
    const int K = g.K, nt = K / BK;
    unsigned voffA[2], voffB[2];
#pragma unroll
    for (int i = 0; i < 2; ++i) { int R, C; stage_rc(tid * 16 + i * 8192, R, C); const int Rb = Epi::PERM ? ((R & ~31) + perm32(R & 31)) : R;
        voffA[i] = (unsigned)(R * g.lda + C) * 2u; voffB[i] = (unsigned)(Rb * g.ldb + C) * 2u; }
    const size_t kstep = (size_t)(BK * 2);
    const size_t hstepA = (size_t)HALF * g.lda * 2, hstepB = (size_t)HALF * g.ldb * 2;
    const size_t tstepA = 2 * hstepA, tstepB = 2 * hstepB;
    const unsigned ldsw = (unsigned)wid * 1024u;
    const int aoff = lds_byte(wr * 64 + fr, fq * 8), boff = lds_byte(wc * 32 + fr, fq * 8);
#define PG8_SA(b, h) (((b) * 2 + (h)) * HTB)
#define PG8_SB(b, h) ((4 + (b) * 2 + (h)) * HTB)
#define PG8_STAGE(bufoff, gbase, voff) do { _Pragma("unroll") for (int _i = 0; _i < 2; ++_i) \
        __builtin_amdgcn_global_load_lds((const unsigned*)((const char*)(gbase) + (voff)[_i]), (LAS unsigned*)(lds + (bufoff) + ldsw + _i * 8192), 16, 0, 0); } while (0)
#define PG8_LDA(dst, b, h) do { _Pragma("unroll") for (int m = 0; m < 4; ++m) _Pragma("unroll") for (int k = 0; k < 2; ++k) dst[m][k] = *(const LAS bf16x8*)(lds + PG8_SA(b, h) + aoff + m * 2048 + k * 1024); } while (0)
#define PG8_LDB(dst, b, h) do { _Pragma("unroll") for (int n = 0; n < 2; ++n) _Pragma("unroll") for (int k = 0; k < 2; ++k) dst[n][k] = *(const LAS bf16x8*)(lds + PG8_SB(b, h) + boff + n * 2048 + k * 1024); } while (0)
#define PG8_CAT(x) __builtin_shufflevector(__builtin_bit_cast(v4i_t, x[0]), __builtin_bit_cast(v4i_t, x[1]), 0, 1, 2, 3, 4, 5, 6, 7)
#define PG8_MMA(ai, bj, At, Bt) do { __builtin_amdgcn_s_setprio(1); \
        if constexpr (F8) { _Pragma("unroll") for (int m = 0; m < 4; ++m) _Pragma("unroll") for (int n = 0; n < 2; ++n) \
            asm volatile("v_mfma_scale_f32_16x16x128_f8f6f4 %0, %1, %2, %0, %3, %3 op_sel_hi:[0,0,0]" : "+v"(acc[ai][bj][m][n]) : "v"(PG8_CAT(Bt[n])), "v"(PG8_CAT(At[m])), "v"(f8one)); } \
        else { _Pragma("unroll") for (int m = 0; m < 4; ++m) _Pragma("unroll") for (int n = 0; n < 2; ++n) _Pragma("unroll") for (int k = 0; k < 2; ++k) \
            acc[ai][bj][m][n] = __builtin_amdgcn_mfma_f32_16x16x32_bf16(Bt[n][k], At[m][k], acc[ai][bj][m][n], 0, 0, 0); } \
        __builtin_amdgcn_s_setprio(0); } while (0)
#define PG8_WAIT_V(n) asm volatile("s_waitcnt vmcnt(" #n ")" ::: "memory")
#define PG8_WAIT_L(n) asm volatile("s_waitcnt lgkmcnt(" #n ")" ::: "memory")
#define PG8_BAR __builtin_amdgcn_s_barrier()
#define PG8_SCHED __builtin_amdgcn_sched_barrier(0)
    Unit cur, nxt; int ui = 0;
    if (!S.next(0, cur)) return;
    const int f8one = 127;
    f32x4 acc[2][2][4][2];
#pragma unroll
    for (int a = 0; a < 2; ++a)
#pragma unroll
        for (int b = 0; b < 2; ++b)
#pragma unroll
            for (int m = 0; m < 4; ++m)
#pragma unroll
                for (int n = 0; n < 2; ++n) acc[a][b][m][n] = (f32x4){0.f, 0.f, 0.f, 0.f};
    bf16x8 At[4][2], B0[2][2], B1[2][2];
    const char* cA = (const char*)g.A + (size_t)cur.pm * tstepA; const char* cB = (const char*)g.Bt + (size_t)cur.pn * tstepB;
    PG8_STAGE(PG8_SB(0, 0), cB, voffB); PG8_STAGE(PG8_SB(0, 1), cB + hstepB, voffB); PG8_STAGE(PG8_SA(0, 0), cA, voffA); PG8_STAGE(PG8_SA(0, 1), cA + hstepA, voffA);
    if (wr == 1) PG8_BAR;
    PG8_WAIT_V(2); PG8_BAR;
    PG8_STAGE(PG8_SB(1, 0), cB + kstep, voffB); PG8_STAGE(PG8_SA(1, 0), cA + kstep, voffA); PG8_STAGE(PG8_SB(1, 1), cB + hstepB + kstep, voffB);
    PG8_WAIT_V(6); PG8_BAR;
    for (;;) {
        const bool has_next = S.next(ui + 1, nxt);
        const char* nA = has_next ? (const char*)g.A + (size_t)nxt.pm * tstepA : cA; const char* nB = has_next ? (const char*)g.Bt + (size_t)nxt.pn * tstepB : cB;
        for (int t = 0; t < nt; t += 2) {
            const bool last = (t == nt - 2);
            const char* a1 = cA + (size_t)(t + 1) * kstep;
            const char* a2 = last ? nA : cA + (size_t)(t + 2) * kstep; const char* b2 = last ? nB : cB + (size_t)(t + 2) * kstep;
            const char* a3 = a2 + kstep; const char* b3 = b2 + kstep;
            PG8_LDB(B0, 0, 0); PG8_LDB(B1, 0, 1); PG8_SCHED; PG8_LDA(At, 0, 0); PG8_STAGE(PG8_SA(1, 1), a1 + hstepA, voffA);
            PG8_WAIT_V(8); PG8_WAIT_L(0); PG8_BAR; PG8_MMA(0, 0, At, B0); PG8_MMA(0, 1, At, B1); PG8_BAR; PG8_SCHED;
            PG8_LDA(At, 0, 1); PG8_STAGE(PG8_SB(0, 0), b2, voffB); PG8_STAGE(PG8_SB(0, 1), b2 + hstepB, voffB); PG8_STAGE(PG8_SA(0, 0), a2, voffA);
            PG8_WAIT_V(8); PG8_WAIT_L(0); PG8_BAR; PG8_MMA(1, 0, At, B0); PG8_MMA(1, 1, At, B1); PG8_BAR; PG8_SCHED;
            PG8_LDB(B0, 1, 0); PG8_LDB(B1, 1, 1); PG8_SCHED; PG8_LDA(At, 1, 0); PG8_STAGE(PG8_SA(0, 1), a2 + hstepA, voffA);
            PG8_WAIT_V(8); PG8_WAIT_L(0); PG8_BAR; PG8_MMA(0, 0, At, B0); PG8_MMA(0, 1, At, B1); PG8_BAR; PG8_SCHED;
            PG8_LDA(At, 1, 1); PG8_STAGE(PG8_SB(1, 0), b3, voffB); PG8_STAGE(PG8_SB(1, 1), b3 + hstepB, voffB); PG8_STAGE(PG8_SA(1, 0), a3, voffA);
            PG8_WAIT_V(8); PG8_WAIT_L(0); PG8_BAR; PG8_MMA(1, 0, At, B0); PG8_MMA(1, 1, At, B1); PG8_BAR; PG8_SCHED;
        }
        if constexpr (ALIGN_EPI) { if (wr == 0) PG8_BAR; }
        if constexpr (F8) { asm volatile("s_nop 15\n\ts_nop 15" ::: "memory"); }
        E(acc, cur, wr, wc, fr, fq);
        if (!has_next) break;
#pragma unroll
        for (int a = 0; a < 2; ++a)
#pragma unroll
            for (int b = 0; b < 2; ++b)
#pragma unroll
                for (int m = 0; m < 4; ++m)
#pragma unroll
                    for (int n = 0; n < 2; ++n) acc[a][b][m][n] = (f32x4){0.f, 0.f, 0.f, 0.f};
        cur = nxt; cA = nA; cB = nB; ++ui;
        if constexpr (ALIGN_EPI) { if (wr == 1) PG8_BAR; }
    }
    PG8_WAIT_V(0);
    if constexpr (!ALIGN_EPI) { if (wr == 0) PG8_BAR; }
    PG8_BAR;
#undef PG8_SA
#undef PG8_SB
#undef PG8_STAGE
#undef PG8_LDA
#undef PG8_LDB
#undef PG8_MMA
#undef PG8_CAT
#undef PG8_WAIT_V
#undef PG8_WAIT_L
#undef PG8_BAR
#undef PG8_SCHED
}
}

struct Frame {
    LAS unsigned char* lds;
    int tid, lane, wave, G, gw, ngw;
    const float* in[20];
    float* out; unsigned char* ws;
};
enum { I_X = 0, I_META, I_LN0G, I_LN0B, I_RELB, I_WIN, I_WUK, I_WUV, I_WGK2, I_BGK, I_GNG, I_WOUT, I_LN1G, I_LN1B, I_WPQ, I_SUBK, I_UTAB, I_VTAB, I_LN2G, I_LN2B };

__device__ __forceinline__ void ln_stats(f32x4 (&v)[8], float& mean, float& rstd) {
    float s = 0.f;
#pragma unroll
    for (int j = 0; j < 8; ++j) s += (v[j].x + v[j].y) + (v[j].z + v[j].w);
    mean = wave_sum(s) * (1.f / DM); float s2 = 0.f;
#pragma unroll
    for (int j = 0; j < 8; ++j) { v[j] = v[j] - mean; s2 += (v[j].x * v[j].x + v[j].y * v[j].y) + (v[j].z * v[j].z + v[j].w * v[j].w); }
    rstd = 1.f / sqrtf(wave_sum(s2) * (1.f / DM) + LN_EPS);
}
__device__ __forceinline__ void ln_row_to_bf16(const float* xrow, const float* g, const float* b, bf16_t* orow, int lane, unsigned* f8row = nullptr, float* stats = nullptr) {
    const f32x4* xr = (const f32x4*)xrow + lane; f32x4 v[8];
#pragma unroll
    for (int j = 0; j < 8; ++j) v[j] = xr[64 * j];
    float mean, rstd; ln_stats(v, mean, rstd);
    if (stats && lane == 0) *(f32x2*)stats = (f32x2){mean, rstd};
    const f32x4* gr = (const f32x4*)g + lane; const f32x4* br = (const f32x4*)b + lane;
    u32x2* o8 = (u32x2*)orow + lane;
#pragma unroll
    for (int j = 0; j < 8; ++j) { const f32x4 gg = gr[64 * j], bb = br[64 * j]; const f32x4 y = v[j] * rstd * gg + bb;
        u32x2 w; w.x = cvtpk(y.x, y.y); w.y = cvtpk(y.z, y.w); o8[64 * j] = w;
        if (f8row) { int q = 0; q = __builtin_amdgcn_cvt_pk_fp8_f32(y.x, y.y, q, false); q = __builtin_amdgcn_cvt_pk_fp8_f32(y.z, y.w, q, true); f8row[lane + 64 * j] = (unsigned)q; } }
}
__device__ __forceinline__ void ln_row_to_f32(const float* xrow, const float* g, const float* b, float* orow, int lane) {
    const f32x4* xr = (const f32x4*)xrow + lane; f32x4 v[8];
#pragma unroll
    for (int j = 0; j < 8; ++j) v[j] = xr[64 * j];
    float mean, rstd; ln_stats(v, mean, rstd);
    const f32x4* gr = (const f32x4*)g + lane; const f32x4* br = (const f32x4*)b + lane;
    f32x4* o = (f32x4*)orow + lane;
#pragma unroll
    for (int j = 0; j < 8; ++j) { const f32x4 gg = gr[64 * j], bb = br[64 * j]; o[64 * j] = v[j] * rstd * gg + bb; }
}
__device__ __forceinline__ void transpose_item(const float* W, int N, bf16_t* WT, int ldt, int row_off, float scale, LAS float* scr, int item, int lane) {
    const int nblk = N / 32, kb = item / nblk, nb = item % nblk, k0 = 64 * kb, n0 = 32 * nb;
#pragma unroll 8
    for (int i = 0; i < 32; ++i) { const int kk = 2 * i + (lane >> 5); scr[kk * 33 + (lane & 31)] = W[(size_t)(k0 + kk) * N + n0 + (lane & 31)]; }
    LDS_WAIT(); asm volatile("" ::: "memory");
    const int c = lane & 7;
#pragma unroll
    for (int j = 0; j < 4; ++j) { const int n = (lane >> 3) + 8 * j; const LAS float* s = scr + (8 * c) * 33 + n;
        u32x4 o; o.x = cvtpk(s[0 * 33] * scale, s[1 * 33] * scale); o.y = cvtpk(s[2 * 33] * scale, s[3 * 33] * scale); o.z = cvtpk(s[4 * 33] * scale, s[5 * 33] * scale); o.w = cvtpk(s[6 * 33] * scale, s[7 * 33] * scale);
        *(u32x4*)(WT + (size_t)(row_off + n0 + n) * ldt + k0 + 8 * c) = o; }
    LDS_WAIT(); asm volatile("" ::: "memory");
}
__device__ __forceinline__ void transpose_item_f8(const float* W, int N, unsigned char* WT, size_t ldt, float scale, LAS float* scr, int item, int lane) {
    const int nblk = N / 32, kb = item / nblk, nb = item % nblk, k0 = 64 * kb, n0 = 32 * nb;
#pragma unroll 8
    for (int i = 0; i < 32; ++i) { const int kk = 2 * i + (lane >> 5); scr[kk * 33 + (lane & 31)] = W[(size_t)(k0 + kk) * N + n0 + (lane & 31)]; }
    LDS_WAIT(); asm volatile("" ::: "memory");
    const int c = lane & 7;
#pragma unroll
    for (int j = 0; j < 4; ++j) { const int n = (lane >> 3) + 8 * j; const LAS float* s = scr + (8 * c) * 33 + n;
        int w0 = 0, w1 = 0;
        w0 = __builtin_amdgcn_cvt_pk_fp8_f32(s[0 * 33] * scale, s[1 * 33] * scale, w0, false); w0 = __builtin_amdgcn_cvt_pk_fp8_f32(s[2 * 33] * scale, s[3 * 33] * scale, w0, true);
        w1 = __builtin_amdgcn_cvt_pk_fp8_f32(s[4 * 33] * scale, s[5 * 33] * scale, w1, false); w1 = __builtin_amdgcn_cvt_pk_fp8_f32(s[6 * 33] * scale, s[7 * 33] * scale, w1, true);
        *(u32x2*)(WT + (size_t)(n0 + n) * ldt + k0 + 8 * c) = (u32x2){(unsigned)w0, (unsigned)w1}; }
    LDS_WAIT(); asm volatile("" ::: "memory");
}
__device__ __forceinline__ void convert_f32_f8(const float* src, unsigned char* dst, float scale, size_t n8, size_t i0, size_t stride) {
    for (size_t i = i0; i < n8; i += stride) { const f32x4 a = ((const f32x4*)src)[2 * i] * scale, b = ((const f32x4*)src)[2 * i + 1] * scale;
        int w0 = 0, w1 = 0;
        w0 = __builtin_amdgcn_cvt_pk_fp8_f32(a.x, a.y, w0, false); w0 = __builtin_amdgcn_cvt_pk_fp8_f32(a.z, a.w, w0, true);
        w1 = __builtin_amdgcn_cvt_pk_fp8_f32(b.x, b.y, w1, false); w1 = __builtin_amdgcn_cvt_pk_fp8_f32(b.z, b.w, w1, true);
        ((u32x2*)dst)[i] = (u32x2){(unsigned)w0, (unsigned)w1}; }
}
__device__ __forceinline__ void convert_f32_bf16(const float* src, bf16_t* dst, size_t n8, size_t i0, size_t stride) {
    for (size_t i = i0; i < n8; i += stride) { const f32x4 a = ((const f32x4*)src)[2 * i], b = ((const f32x4*)src)[2 * i + 1];
        u32x4 w; w.x = cvtpk(a.x, a.y); w.y = cvtpk(a.z, a.w); w.z = cvtpk(b.x, b.y); w.w = cvtpk(b.z, b.w); ((u32x4*)dst)[i] = w; }
}
__device__ __forceinline__ int t5_bucket(int rel) {
    const int n = rel < 0 ? -rel : rel;
    const int f = n < 8 ? n : (n < 12 ? 8 : (n < 16 ? 9 : (n < 23 ? 10 : (n < 32 ? 11 : (n < 46 ? 12 : (n < 64 ? 13 : (n < 91 ? 14 : 15)))))));
    return (rel > 0 ? 16 : 0) + f;
}
constexpr float WPQ_S = 64.f;
constexpr int BT_OFF = 2080, BT_N = 2144;

__device__ __forceinline__ void p0_prologue(Frame& F) {
    LAS float* scr = (LAS float*)(F.lds + F.wave * 8704);
    bf16_t* H0 = (bf16_t*)(F.ws + WS_H0);
    for (int m = F.gw; m < T + NMETA; m += F.ngw) {
        const float* src = m < T ? F.in[I_X] + (size_t)m * DM : F.in[I_META] + (size_t)(m - T) * DM;
        ln_row_to_bf16(src, F.in[I_LN0G], F.in[I_LN0B], H0 + (size_t)m * DM, F.lane, nullptr, m < T ? (float*)(F.ws + WS_ST0) + 2 * (size_t)m : nullptr);
    }
    { u32x4* z = (u32x4*)(H0 + (size_t)(T + NMETA) * DM); const size_t n = (size_t)(TM - T - NMETA) * DM / 8;
      for (size_t i = (size_t)F.gw * 64 + F.lane; i < n; i += (size_t)F.ngw * 64) z[i] = (u32x4){0u, 0u, 0u, 0u}; }
    constexpr int I_IN = (DM / 64) * (INC / 32), I_O = (DM / 64) * (DM / 32), I_KV = 8 * (256 / 64) * (128 / 32);
    constexpr int NITEMS = I_IN + 2 * I_O + 2 * I_KV;
    for (int it = F.gw; it < NITEMS; it += F.ngw) {
        int r = it;
        if (r < I_IN) { transpose_item(F.in[I_WIN], INC, (bf16_t*)(F.ws + WS_WIN), DM, 0, 1.f, scr, r, F.lane); continue; } r -= I_IN;
        if (r < I_O) { transpose_item(F.in[I_WOUT], DM, (bf16_t*)(F.ws + WS_WO), DM, 0, 1.f, scr, r, F.lane); continue; } r -= I_O;
        if (r < I_O) { transpose_item(F.in[I_WPQ], DM, (bf16_t*)(F.ws + WS_WPQ), DM, 0, 1.f, scr, r, F.lane); continue; } r -= I_O;
        if (r < I_KV) { const int h = r / 16; transpose_item(F.in[I_WUK] + (size_t)h * 256 * 128, 128, (bf16_t*)(F.ws + WS_WKV), 256, h * 128, 0.08838834764831845f * LOG2E, scr, r % 16, F.lane); continue; } r -= I_KV;
        { const int h = r / 16; transpose_item(F.in[I_WUV] + (size_t)h * 256 * 128, 128, (bf16_t*)(F.ws + WS_WKV), 256, 1024 + h * 128, 1.f, scr, r % 16, F.lane); }
    }
    convert_f32_bf16(F.in[I_SUBK], (bf16_t*)(F.ws + WS_SKB), (size_t)16 * 128 * 128 / 8, (size_t)F.gw * 64 + F.lane, (size_t)F.ngw * 64);
    { float* bt = (float*)(F.ws + WS_BT);
      for (int i = F.gw * 64 + F.lane; i < 8 * BT_N; i += F.ngw * 64) { const int h = i / BT_N, rel = i % BT_N - BT_OFF; bt[i] = F.in[I_RELB][t5_bucket(rel) * 8 + h] * LOG2E; } }
}

__device__ __forceinline__ void kv_meta(Frame& F) {
    const bf16_t* PROJ = (const bf16_t*)(F.ws + WS_PROJ); const bf16_t* WKV = (const bf16_t*)(F.ws + WS_WKV); bf16_t* KVP = (bf16_t*)(F.ws + WS_KVP);
    const int l16 = F.lane & 15, q4 = F.lane >> 4;
    for (int j = F.gw; j < 128; j += F.ngw) {
        f32x4 acc = {0.f, 0.f, 0.f, 0.f};
#pragma unroll
        for (int s = 0; s < 8; ++s) acc = __builtin_amdgcn_mfma_f32_16x16x32_bf16(*(const bf16x8*)(PROJ + (size_t)(T + l16) * INP + C_CKV + 32 * s + 8 * q4), *(const bf16x8*)(WKV + (size_t)(16 * j + l16) * 256 + 32 * s + 8 * q4), acc, 0, 0, 0);
#pragma unroll
        for (int r = 0; r < 4; ++r) KVP[(size_t)(T + 4 * q4 + r) * 2048 + 16 * j + l16] = f2bf(acc[r]);
    }
    { u32x4* z = (u32x4*)(KVP + (size_t)(T + NMETA) * 2048); const int n = 48 * 2048 / 8;
      for (int i = F.gw * 64 + F.lane; i < n; i += F.ngw * 64) z[i] = (u32x4){0u, 0u, 0u, 0u}; }
}
__device__ __forceinline__ void idx_unit(Frame& F, int b, int g) {
    const bf16_t* PROJ = (const bf16_t*)(F.ws + WS_PROJ);
    unsigned* BM = (unsigned*)(F.ws + WS_BM);
    const int lane = F.lane, n = lane & 31, hi = lane >> 5, w = F.wave;
    const int c = g >> 2, nrt = 2 * (c + 1), ntile = nrt + 1;
    LAS float* scall = (LAS float*)(F.lds);
    LAS float* iwl = (LAS float*)(F.lds + RING_BYTES);
    const float NINF = -__builtin_inff();
    if (F.tid < 256) iwl[F.tid] = bf2f(PROJ[(size_t)(b * SEQ + 16 * g + (F.tid >> 4)) * INP + C_IW + (F.tid & 15)]);
    __syncthreads();
    for (int mh = 0; mh < 2; ++mh) {
        bf16x8 af[4][4];
#pragma unroll
        for (int mt = 0; mt < 4; ++mt)
#pragma unroll
            for (int s = 0; s < 4; ++s) af[mt][s] = *(const bf16x8*)(PROJ + (size_t)(b * SEQ + 16 * g + 2 * (4 * mh + mt) + (n >> 4)) * INP + C_IQ + (n & 15) * 64 + 16 * s + 8 * hi);
        bf16x8 b0[4], b1[4], b2[4];
#define IDX_LOADB(dst, tt) do { const int t_ = (tt); if (t_ < ntile) { const size_t krow_ = t_ < nrt ? (size_t)(b * SEQ + 32 * t_ + n) : (size_t)(T + n); \
            _Pragma("unroll") for (int s = 0; s < 4; ++s) dst[s] = *(const bf16x8*)(PROJ + krow_ * INP + C_IK + 16 * s + 8 * hi); } } while (0)
#define IDX_TILE(bc, tt) do { const int t_ = (tt); if (t_ < ntile) { const bool padkey = (t_ == nrt && n >= NMETA); \
            _Pragma("unroll") for (int mt = 0; mt < 4; ++mt) { const int qa = 2 * (4 * mh + mt); \
                f32x16 acc = {}; \
                _Pragma("unroll") for (int s = 0; s < 4; ++s) acc = __builtin_amdgcn_mfma_f32_32x32x16_bf16(af[mt][s], bc[s], acc, 0, 0, 0); \
                const f32x4 wa0 = *(const LAS f32x4*)(iwl + qa * 16 + 4 * hi), wa1 = *(const LAS f32x4*)(iwl + qa * 16 + 8 + 4 * hi); \
                const f32x4 wb0 = *(const LAS f32x4*)(iwl + (qa + 1) * 16 + 4 * hi), wb1 = *(const LAS f32x4*)(iwl + (qa + 1) * 16 + 8 + 4 * hi); \
                float p0 = 0.f, p1 = 0.f; \
                _Pragma("unroll") for (int r = 0; r < 4; ++r) { p0 += fmaxf(acc[r], 0.f) * wa0[r] + fmaxf(acc[4 + r], 0.f) * wa1[r]; p1 += fmaxf(acc[8 + r], 0.f) * wb0[r] + fmaxf(acc[12 + r], 0.f) * wb1[r]; } \
                const auto rr = __builtin_amdgcn_permlane32_swap(__float_as_uint(p0), __float_as_uint(p1), false, false); \
                float tot = __uint_as_float(rr[0]) + __uint_as_float(rr[1]); \
                if (padkey) tot = NINF; \
                scall[(qa + hi) * 2112 + 32 * t_ + n] = tot; } } } while (0)
        IDX_LOADB(b0, w); IDX_LOADB(b1, w + 8); IDX_LOADB(b2, w + 16);
        for (int t = w; t < ntile; t += 24) {
            IDX_TILE(b0, t);      IDX_LOADB(b0, t + 24);
            IDX_TILE(b1, t + 8);  IDX_LOADB(b1, t + 32);
            IDX_TILE(b2, t + 16); IDX_LOADB(b2, t + 40);
        }
#undef IDX_LOADB
#undef IDX_TILE
    }
    __syncthreads();
    LAS float* sc = scall + (2 * w + hi) * 2112;
    const int q0 = 16 * g + 2 * w;
    float v[66];
#pragma unroll
    for (int t = 0; t < 66; ++t) v[t] = NINF;
#pragma unroll
    for (int t = 0; t < 65; ++t) if (t <= nrt) v[t] = sc[32 * t + n];
    float thr = -3.0e38f;
    if (c >= 3) {
        float mn = __builtin_inff(), mx = NINF;
#pragma unroll
        for (int t = 0; t < 65; ++t) { mx = fmaxf(mx, v[t]); mn = fminf(mn, v[t] > NINF ? v[t] : mn); }
#pragma unroll
        for (int o = 1; o < 32; o <<= 1) { mn = fminf(mn, __shfl_xor(mn, o)); mx = fmaxf(mx, __shfl_xor(mx, o)); }
        float lo = mn, hh = mx; bool done = false; thr = mn;
        for (int it = 0; it < 64; ++it) {
            const float mid = 0.5f * lo + 0.5f * hh;
            if (!done && !(mid > lo && mid < hh)) { thr = lo; done = true; }
            if (__all(done)) break;
            int cnt = 0;
#pragma unroll
            for (int t = 0; t < 22; ++t) cnt += (v[t] >= mid) ? 1 : 0;
            if (nrt >= 22) {
#pragma unroll
                for (int t = 22; t < 44; ++t) cnt += (v[t] >= mid) ? 1 : 0; }
            if (nrt >= 44) {
#pragma unroll
                for (int t = 44; t < 65; ++t) cnt += (v[t] >= mid) ? 1 : 0; }
#pragma unroll
            for (int o = 1; o < 32; o <<= 1) cnt += __shfl_xor(cnt, o);
            if (!done) { if (cnt == 256) { thr = mid; done = true; } else if (cnt > 256) lo = mid; else hh = mid; }
        }
        if (!done) thr = lo;
    }
    unsigned w0 = 0u, w1 = 0u, w2 = 0u;
#pragma unroll
    for (int t = 0; t < 65; ++t) {
        const unsigned long long bal = __ballot(v[t] >= thr && v[t] > NINF);
        const unsigned mine = hi ? (unsigned)(bal >> 32) : (unsigned)bal;
        const bool ismeta = (t == nrt);
        if (t < 32) { if (!ismeta && n == t) w0 = mine; } else if (t < 64) { if (!ismeta && n == t - 32) w1 = mine; }
        if (ismeta && n == 0) w2 = mine;
    }
    unsigned* bm = BM + (size_t)(b * SEQ + q0 + hi) * 66;
    bm[n] = w0; bm[32 + n] = w1; if (n < 2) bm[64 + n] = w2;
}
__device__ __forceinline__ void idx_phase(Frame& F) {
    for (int u = blockIdx.x; u < NB * 128; u += F.G) { const int b = u >> 7, gr = u & 127, g = ((b >> 1) & 1) ? 127 - gr : gr;
        idx_unit(F, b, g); __syncthreads(); }
}

namespace att {
constexpr int SHM_V = 64 * 128 * 2, SHM_K = 64 * 128 * 2;
constexpr int OFF_V = 0, OFF_K = 2 * SHM_V, OFF_WS = OFF_K + 2 * SHM_K, OFF_BT = OFF_WS + NWAVES * 256, BTW = 384, BT_ZERO = 320;
#define KSWZ(row, colB) ((row) * 256 + ((colB) ^ (((row) & 7) << 4)))
__device__ __forceinline__ int v_st(int k, int c) { const int kk = (k & ~0xC) | ((k & 4) << 1) | ((k & 8) >> 1); return ((kk >> 3) * 4 + (c >> 5)) * 512 + ((kk & 7) * 32 + (c & 31)) * 2; }
__device__ __forceinline__ int v_rd_base(int lane) { return ((lane & 3) << 3) | (((lane >> 2) & 3) << 6) | (((lane >> 4) & 1) << 5) | (((lane >> 5) & 1) << 8); }
constexpr int v_rd_off(int d0, int ks, int half) { return d0 * 512 + ks * 4096 + half * 2048; }
template <int OFF> __device__ __forceinline__ s16x4 tr_read(int vb) { s16x4 r; asm volatile("ds_read_b64_tr_b16 %0, %1 offset:%2" : "=&v"(r) : "v"(vb), "i"(OFF) : "memory"); return r; }
template <int D0> __device__ __forceinline__ void pv_one(f32x16& od, int vb, bf16x8 pa0, bf16x8 pa1, bf16x8 pa2, bf16x8 pa3) {
    const s16x4 l0 = tr_read<v_rd_off(D0, 0, 0)>(vb), h0 = tr_read<v_rd_off(D0, 0, 1)>(vb), l1 = tr_read<v_rd_off(D0, 1, 0)>(vb), h1 = tr_read<v_rd_off(D0, 1, 1)>(vb);
    const s16x4 l2 = tr_read<v_rd_off(D0, 2, 0)>(vb), h2 = tr_read<v_rd_off(D0, 2, 1)>(vb), l3 = tr_read<v_rd_off(D0, 3, 0)>(vb), h3 = tr_read<v_rd_off(D0, 3, 1)>(vb);
    asm volatile("s_waitcnt lgkmcnt(0)" ::: "memory"); SBAR();
#define PK(L, H) (bf16x8){L[0], L[1], L[2], L[3], H[0], H[1], H[2], H[3]}
    od = __builtin_amdgcn_mfma_f32_32x32x16_bf16(pa0, PK(l0, h0), od, 0, 0, 0);
    od = __builtin_amdgcn_mfma_f32_32x32x16_bf16(pa1, PK(l1, h1), od, 0, 0, 0);
    od = __builtin_amdgcn_mfma_f32_32x32x16_bf16(pa2, PK(l2, h2), od, 0, 0, 0);
    od = __builtin_amdgcn_mfma_f32_32x32x16_bf16(pa3, PK(l3, h3), od, 0, 0, 0);
#undef PK
}
__device__ __forceinline__ void qkt(f32x16& p0, f32x16& p1, const LAS unsigned char* Ks, const bf16x8* qr, int r32, int hi) {
    p0 = f32x16{}; p1 = f32x16{};
#pragma unroll
    for (int d0 = 0; d0 < 8; ++d0) { const int cb = (d0 * 16 + hi * 8) * 2;
        const bf16x8 b0 = *(const LAS bf16x8*)(Ks + KSWZ(r32, cb));
        const bf16x8 b1 = *(const LAS bf16x8*)(Ks + KSWZ(32 + r32, cb));
        p0 = __builtin_amdgcn_mfma_f32_32x32x16_bf16(b0, qr[d0], p0, 0, 0, 0);
        p1 = __builtin_amdgcn_mfma_f32_32x32x16_bf16(b1, qr[d0], p1, 0, 0, 0); }
}
template <bool NEAR>
__device__ __forceinline__ void tile_sm(f32x16& p0, f32x16& p1, float& m_reg, float& l_reg, float& alpha, bf16x8& pa0, bf16x8& pa1, bf16x8& pa2, bf16x8& pa3,
                                        float cb, const LAS float* btl, unsigned mlo, unsigned mhi, int hi) {
    if (NEAR) {
#pragma unroll
        for (int r = 0; r < 16; ++r) { p0[r] += btl[(r & 3) + 8 * (r >> 2)]; p1[r] += btl[32 + (r & 3) + 8 * (r >> 2)]; }
    }
    float pmax = p0[0];
#pragma unroll
    for (int r = 1; r < 16; ++r) pmax = fmaxf(pmax, p0[r]);
#pragma unroll
    for (int r = 0; r < 16; ++r) pmax = fmaxf(pmax, p1[r]);
    { const auto rr = __builtin_amdgcn_permlane32_swap(__float_as_uint(pmax), __float_as_uint(pmax), false, false); pmax = fmaxf(__uint_as_float(rr[0]), __uint_as_float(rr[1])); }
    if (!NEAR) pmax += cb;
    const float mn = fmaxf(m_reg, pmax); alpha = __builtin_amdgcn_exp2f(m_reg - mn); m_reg = mn;
    const float off = (NEAR ? 0.f : cb) - mn;
    const unsigned w0 = mlo >> (4 * hi), w1 = mhi >> (4 * hi);
    float ps = 0.f;
#pragma unroll
    for (int r = 0; r < 16; ++r) { const int pos = (r & 3) + 8 * (r >> 2);
        const float e0 = __builtin_amdgcn_exp2f(p0[r] + off), e1 = __builtin_amdgcn_exp2f(p1[r] + off);
        p0[r] = __uint_as_float(__float_as_uint(e0) & (unsigned)__builtin_amdgcn_sbfe((int)w0, pos, 1));
        p1[r] = __uint_as_float(__float_as_uint(e1) & (unsigned)__builtin_amdgcn_sbfe((int)w1, pos, 1));
        ps += p0[r] + p1[r]; }
    { const auto rr = __builtin_amdgcn_permlane32_swap(__float_as_uint(ps), __float_as_uint(ps), false, false); ps = __uint_as_float(rr[0]) + __uint_as_float(rr[1]); }
    l_reg = l_reg * alpha + ps;
#define PK4(P, BASE, OUT) do { unsigned a0 = cvtpk(P[BASE + 0], P[BASE + 1]), a1 = cvtpk(P[BASE + 2], P[BASE + 3]);   \
    unsigned b0 = cvtpk(P[BASE + 4], P[BASE + 5]), b1 = cvtpk(P[BASE + 6], P[BASE + 7]);                              \
    auto r0 = __builtin_amdgcn_permlane32_swap(a0, b0, false, false); auto r1 = __builtin_amdgcn_permlane32_swap(a1, b1, false, false); \
    u32x4 w = {r0[0], r1[0], r0[1], r1[1]}; OUT = *reinterpret_cast<bf16x8*>(&w); } while (0)
    PK4(p0, 0, pa0); PK4(p0, 8, pa1); PK4(p1, 0, pa2); PK4(p1, 8, pa3);
#undef PK4
}
__device__ __forceinline__ void attn_unit(Frame& F, int b, int h, int qb) {
    const bf16_t* PROJ = (const bf16_t*)(F.ws + WS_PROJ); const bf16_t* KVP = (const bf16_t*)(F.ws + WS_KVP);
    const unsigned long long* BM = (const unsigned long long*)(F.ws + WS_BM);
    const float* BT = (const float*)(F.ws + WS_BT);
    bf16_t* YM = (bf16_t*)(F.ws + WS_YMIX);
    LAS unsigned char* lds = F.lds;
    const int tid = F.tid, wid = F.wave, lane = F.lane, r32 = lane & 31, hi = lane >> 5;
    LAS unsigned char* V_lds = lds + OFF_V; LAS unsigned char* K_lds = lds + OFF_K;
    LAS float* wsl = (LAS float*)(lds + OFF_WS) + wid * 64; LAS float* li_l = wsl; LAS float* al_l = wsl + 32;
    LAS float* btw = (LAS float*)(lds + OFF_BT) + wid * BTW;
    for (int i = lane; i < BTW; i += 64) btw[i] = BT[h * BT_N + (i - BT_ZERO + BT_OFF)];
    const int q0w = 256 * qb + 32 * wid, q = q0w + r32;
    const size_t tq = (size_t)(b * SEQ + q);
    const int nreal = 4 * (qb + 1), NT = nreal + 1;
    float m_reg = -1e30f, l_reg = 0.f; f32x16 o[4] = {}; bf16x8 qr[8];
    { const bf16_t* Qw = PROJ + tq * INP + C_AQ + h * 128 + hi * 8;
#pragma unroll
      for (int d0 = 0; d0 < 8; ++d0) qr[d0] = *(const bf16x8*)(Qw + d0 * 16); }
    const int sr = tid >> 4, sc = (tid & 15) * 8, vst0 = v_st(sr, sc), vst1 = v_st(32 + sr, sc);
    const int vb0 = (int)(unsigned)(size_t)V_lds + v_rd_base(lane);
    bf16x8 vs0, vs1, ks0, ks1;
    const bf16_t* Kh = KVP + h * 128 + sc; const bf16_t* Vh = KVP + 1024 + h * 128 + sc;
#define A_SLOAD(j) do { const size_t kb_ = (j) < nreal ? (size_t)(b * SEQ + 64 * (j)) : (size_t)T; \
    vs0 = *(const bf16x8*)(Vh + (kb_ + sr) * 2048); vs1 = *(const bf16x8*)(Vh + (kb_ + 32 + sr) * 2048); \
    ks0 = *(const bf16x8*)(Kh + (kb_ + sr) * 2048); ks1 = *(const bf16x8*)(Kh + (kb_ + 32 + sr) * 2048); } while (0)
#define A_SWRITE(bf) do { *(LAS bf16x8*)(V_lds + (bf) * SHM_V + vst0) = vs0; *(LAS bf16x8*)(V_lds + (bf) * SHM_V + vst1) = vs1; \
    *(LAS bf16x8*)(K_lds + (bf) * SHM_K + KSWZ(sr, sc * 2)) = ks0; *(LAS bf16x8*)(K_lds + (bf) * SHM_K + KSWZ(32 + sr, sc * 2)) = ks1; } while (0)
#define A_RESC(a) do { if (__any((a) < 1.f)) { if (hi == 0) al_l[r32] = (a); asm volatile("s_waitcnt lgkmcnt(0)" ::: "memory"); \
    _Pragma("unroll") for (int d = 0; d < 4; ++d) _Pragma("unroll") for (int r = 0; r < 16; ++r) o[d][r] *= al_l[crow(r, hi)]; } } while (0)
    const float cbfar = BT[h * BT_N + (-200 + BT_OFF)];
    A_SLOAD(0); unsigned long long mk = BM[tq * 33 + 0];
    VM_WAIT(); A_SWRITE(0); __syncthreads();
    for (int j = 0; j < NT; ++j) {
        const int cur = j & 1; const bool more = (j + 1 < NT);
        unsigned long long mkn = 0ull;
        if (more) { A_SLOAD(j + 1); mkn = BM[tq * 33 + ((j + 1) < nreal ? (j + 1) : 32)]; }
        f32x16 p0, p1; float alpha; bf16x8 pa0, pa1, pa2, pa3;
        qkt(p0, p1, K_lds + cur * SHM_K, qr, r32, hi);
        const bool meta = (j >= nreal);
        const bool nearT = meta ? (q0w < 96) : (64 * j + 63 - q0w > -91);
        if (nearT) { const int base = (meta ? (-16 - q) : (64 * j - q)) + BT_ZERO + 4 * hi;
            tile_sm<true>(p0, p1, m_reg, l_reg, alpha, pa0, pa1, pa2, pa3, 0.f, btw + base, (unsigned)mk, (unsigned)(mk >> 32), hi); }
        else tile_sm<false>(p0, p1, m_reg, l_reg, alpha, pa0, pa1, pa2, pa3, cbfar, btw, (unsigned)mk, (unsigned)(mk >> 32), hi);
        A_RESC(alpha);
        const int vb = vb0 + cur * SHM_V;
        pv_one<0>(o[0], vb, pa0, pa1, pa2, pa3); pv_one<1>(o[1], vb, pa0, pa1, pa2, pa3); pv_one<2>(o[2], vb, pa0, pa1, pa2, pa3); pv_one<3>(o[3], vb, pa0, pa1, pa2, pa3);
        if (more) { VM_WAIT(); A_SWRITE(cur ^ 1); }
        mk = mkn;
        __syncthreads();
    }
    if (hi == 0) li_l[r32] = l_reg; asm volatile("s_waitcnt lgkmcnt(0)" ::: "memory");
    float rli[16];
#pragma unroll
    for (int r = 0; r < 16; ++r) rli[r] = __builtin_amdgcn_rcpf(li_l[crow(r, hi)]);
    bf16_t* Ow = YM + (size_t)(b * SEQ + q0w) * DM + h * 128;
#pragma unroll
    for (int r = 0; r < 16; ++r) { const int orow = crow(r, hi);
#pragma unroll
        for (int d0 = 0; d0 < 4; ++d0) Ow[(size_t)orow * DM + d0 * 32 + r32] = f2bf(o[d0][r] * rli[r]); }
    __syncthreads();
#undef A_SLOAD
#undef A_SWRITE
#undef A_RESC
}
__device__ __forceinline__ void attn_phase(Frame& F) {
    for (int u = blockIdx.x; u < 512; u += F.G) { const int bh = (u >> 2) & 63, p = u & 3, qb = (u >= 256) ? 7 - p : p;
        attn_unit(F, bh >> 3, bh & 7, qb); }
}
#undef KSWZ
}

__device__ __forceinline__ size_t gla_row(int b, int c, int i) { return c == 0 ? (size_t)(T + i - 48) : (size_t)(b * SEQ + (c - 1) * 64 + i); }
__device__ __forceinline__ void gla_prep_unit(Frame& F, int b, int h, int c) {
    const bf16_t* PROJ = (const bf16_t*)(F.ws + WS_PROJ);
    bf16_t* QT = (bf16_t*)(F.ws + WS_QT); bf16_t* KTT = (bf16_t*)(F.ws + WS_KTT); bf16_t* VT = (bf16_t*)(F.ws + WS_VT); bf16_t* AT = (bf16_t*)(F.ws + WS_AT);
    float* EB = (float*)(F.ws + WS_EB);
    LAS unsigned char* lds = F.lds;
    LAS bf16_t* Qs = (LAS bf16_t*)lds;
    LAS bf16_t* Ks = (LAS bf16_t*)(lds + 64 * 136 * 2);
    LAS float* tot = (LAS float*)(lds + 2 * 64 * 136 * 2);
    LAS float* grs = tot + 512;
    const int tid = F.tid, d = tid & 127, ig = tid >> 7, G = b * NCH + c;
    u32x4 gl = {0u, 0u, 0u, 0u};
    if (tid < 128) { const int i = tid >> 1; if (c > 0 || i >= 48) gl = *(const u32x4*)(PROJ + gla_row(b, c, i) * INP + C_GR + 8 * (tid & 1)); }
    unsigned qk[16];
#pragma unroll
    for (int ii = 0; ii < 16; ++ii) { const int i = 16 * ig + ii; qk[ii] = 0u;
        if (c > 0 || i >= 48) { const size_t row = gla_row(b, c, i); qk[ii] = (unsigned)PROJ[row * INP + C_GQ + h * 128 + d] | ((unsigned)PROJ[row * INP + C_GK + h * 128 + d] << 16); } }
    unsigned vpk[16];
    { const int v = tid & 255, ih = tid >> 8;
#pragma unroll
      for (int j = 0; j < 16; ++j) { const int i0 = 32 * ih + 2 * j; unsigned lo = 0u, hi2 = 0u;
          if (c > 0 || i0 >= 48) lo = PROJ[gla_row(b, c, i0) * INP + C_GV + h * 256 + v];
          if (c > 0 || i0 + 1 >= 48) hi2 = PROJ[gla_row(b, c, i0 + 1) * INP + C_GV + h * 256 + v];
          vpk[j] = lo | (hi2 << 16); } }
    float wv[16];
#pragma unroll
    for (int r = 0; r < 16; ++r) wv[r] = F.in[I_WGK2][r * 512 + h * 128 + d];
    const float bg = F.in[I_BGK][h * 128 + d];
    if (tid < 128) { LAS float* gp = grs + (tid >> 1) * 16 + 8 * (tid & 1);
        gp[0] = bflo(gl.x); gp[1] = bfhi(gl.x); gp[2] = bflo(gl.y); gp[3] = bfhi(gl.y); gp[4] = bflo(gl.z); gp[5] = bfhi(gl.z); gp[6] = bflo(gl.w); gp[7] = bfhi(gl.w); }
    __syncthreads();
    float bl[16]; float run = 0.f;
#pragma unroll
    for (int ii = 0; ii < 16; ++ii) { const int i = 16 * ig + ii; const bool valid = (c > 0) || (i >= 48);
        const f32x4 a0 = *(const LAS f32x4*)(grs + i * 16), a1 = *(const LAS f32x4*)(grs + i * 16 + 4), a2 = *(const LAS f32x4*)(grs + i * 16 + 8), a3 = *(const LAS f32x4*)(grs + i * 16 + 12);
        float x = bg + a0.x * wv[0] + a0.y * wv[1] + a0.z * wv[2] + a0.w * wv[3] + a1.x * wv[4] + a1.y * wv[5] + a1.z * wv[6] + a1.w * wv[7]
                     + a2.x * wv[8] + a2.y * wv[9] + a2.z * wv[10] + a2.w * wv[11] + a3.x * wv[12] + a3.y * wv[13] + a3.z * wv[14] + a3.w * wv[15];
        const float gk = valid ? (fminf(x, 0.f) - __logf(1.f + __expf(-fabsf(x)))) * (1.f / 16.f) : 0.f;
        run += gk; bl[ii] = run; }
    tot[ig * 128 + d] = run;
    __syncthreads();
    float offs = 0.f, blast = 0.f;
#pragma unroll
    for (int gI = 0; gI < 4; ++gI) { const float tv = tot[gI * 128 + d]; blast += tv; if (gI < ig) offs += tv; }
#pragma unroll
    for (int ii = 0; ii < 16; ++ii) { const int i = 16 * ig + ii;
        const float bc = bl[ii] + offs;
        const bf16_t qt = f2bf(bflo(qk[ii]) * __expf(bc) * 0.08838834764831845f), kt = f2bf(bfhi(qk[ii]) * __expf(-bc));
        QT[((size_t)G * 64 + i) * 512 + h * 128 + d] = qt;
        Qs[i * 136 + d] = qt; Ks[i * 136 + d] = kt; }
    if (ig == 0) EB[(size_t)G * 512 + h * 128 + d] = __expf(blast);
    { const int v = tid & 255, ih = tid >> 8; u32x4* dst = (u32x4*)(VT + ((size_t)G * 1024 + h * 256 + v) * 64 + 32 * ih);
#pragma unroll
      for (int j = 0; j < 4; ++j) dst[j] = (u32x4){vpk[4 * j], vpk[4 * j + 1], vpk[4 * j + 2], vpk[4 * j + 3]}; }
    __syncthreads();
    { const int jg = ig; unsigned pk[8];
#pragma unroll
      for (int j = 0; j < 8; ++j) pk[j] = (unsigned)Ks[(16 * jg + 2 * j) * 136 + d] | ((unsigned)Ks[(16 * jg + 2 * j + 1) * 136 + d] << 16);
      u32x4* dst = (u32x4*)(KTT + (((size_t)G * 4 + h) * 128 + d) * 64 + 16 * jg);
      dst[0] = (u32x4){pk[0], pk[1], pk[2], pk[3]}; dst[1] = (u32x4){pk[4], pk[5], pk[6], pk[7]}; }
    if (F.wave < 4) { const int w = F.wave, ib = (w == 0 || w == 3) ? 0 : 1, jb = (w == 2 || w == 3) ? 1 : 0; const int n = F.lane & 31, hi = F.lane >> 5;
        f32x16 acc = {};
        if (w < 3) {
#pragma unroll
            for (int s = 0; s < 8; ++s) { const bf16x8 a = *(const LAS bf16x8*)(Qs + (32 * ib + n) * 136 + 16 * s + 8 * hi), bb = *(const LAS bf16x8*)(Ks + (32 * jb + n) * 136 + 16 * s + 8 * hi);
                acc = __builtin_amdgcn_mfma_f32_32x32x16_bf16(a, bb, acc, 0, 0, 0); } }
        bf16_t* dst = AT + (((size_t)G * 4 + h) * 64) * 64;
#pragma unroll
        for (int r = 0; r < 16; ++r) { const int i = 32 * ib + crow(r, hi), j = 32 * jb + n; dst[i * 64 + j] = f2bf(j <= i ? acc[r] : 0.f); } }
    __syncthreads();
}
__device__ __forceinline__ void gla_prep_phase(Frame& F) {
    for (int u = blockIdx.x; u < NB * NCH * 4; u += F.G) { const int h = u & 3, bc = u >> 2; gla_prep_unit(F, bc / NCH, h, bc % NCH); }
}
struct GlaOps { bf16x8 ka0, ka1, v00, v01, v10, v11; f32x4 eb; };
__device__ __forceinline__ void gla_load_ops(GlaOps& o, const bf16_t* KTT, const bf16_t* VT, const float* EB, int G, int h, int vs, int w, int l16, int q4) {
    const bf16_t* kt = KTT + (((size_t)G * 4 + h) * 128 + 16 * w + l16) * 64 + 8 * q4;
    const bf16_t* vt = VT + ((size_t)G * 1024 + h * 256 + 32 * vs + l16) * 64 + 8 * q4;
    o.ka0 = *(const bf16x8*)(kt); o.ka1 = *(const bf16x8*)(kt + 32);
    o.v00 = *(const bf16x8*)(vt); o.v01 = *(const bf16x8*)(vt + 32); o.v10 = *(const bf16x8*)(vt + 16 * 64); o.v11 = *(const bf16x8*)(vt + 16 * 64 + 32);
    o.eb = *(const f32x4*)(EB + (size_t)G * 512 + h * 128 + 16 * w + 4 * q4);
}
__device__ __forceinline__ void gla_scan_task(Frame& F, int b, int h, int vs, int w) {
    const bf16_t* KTT = (const bf16_t*)(F.ws + WS_KTT); const bf16_t* VT = (const bf16_t*)(F.ws + WS_VT); const float* EB = (const float*)(F.ws + WS_EB);
    bf16_t* SST = (bf16_t*)(F.ws + WS_SST);
    const int lane = F.lane, l16 = lane & 15, q4 = lane >> 4, G0 = b * NCH;
    f32x4 S0 = {0.f, 0.f, 0.f, 0.f}, S1 = {0.f, 0.f, 0.f, 0.f};
    for (int c0 = 0; c0 < NCH - 1; c0 += 6) {
        GlaOps o[6];
#pragma unroll
        for (int k = 0; k < 6; ++k) if (c0 + k < NCH - 1) gla_load_ops(o[k], KTT, VT, EB, G0 + c0 + k, h, vs, w, l16, q4);
        u32x2 r0[6], r1[6];
#pragma unroll
        for (int k = 0; k < 6; ++k) if (c0 + k < NCH - 1) {
            S0 = __builtin_amdgcn_mfma_f32_16x16x32_bf16(o[k].ka0, o[k].v00, S0, 0, 0, 0); S0 = __builtin_amdgcn_mfma_f32_16x16x32_bf16(o[k].ka1, o[k].v01, S0, 0, 0, 0);
            S1 = __builtin_amdgcn_mfma_f32_16x16x32_bf16(o[k].ka0, o[k].v10, S1, 0, 0, 0); S1 = __builtin_amdgcn_mfma_f32_16x16x32_bf16(o[k].ka1, o[k].v11, S1, 0, 0, 0);
            S0 = S0 * o[k].eb; S1 = S1 * o[k].eb;
            r0[k] = (u32x2){cvtpk(S0[0], S0[1]), cvtpk(S0[2], S0[3])}; r1[k] = (u32x2){cvtpk(S1[0], S1[1]), cvtpk(S1[2], S1[3])}; }
#pragma unroll
        for (int k = 0; k < 6; ++k) if (c0 + k < NCH - 1) {
            bf16_t* so = SST + (((size_t)(G0 + c0 + k) * 4 + h) * 256 + 32 * vs + l16) * 128 + 16 * w + 4 * q4;
            *(u32x2*)(so) = r0[k]; *(u32x2*)(so + 16 * 128) = r1[k]; }
    }
}
__device__ __forceinline__ void gla_scan_phase(Frame& F) {
    for (int u = F.gw; u < NB * 4 * 8 * 8; u += F.ngw) gla_scan_task(F, u >> 8, (u >> 6) & 3, (u >> 3) & 7, u & 7);
}
__device__ __forceinline__ void gla_out_unit(Frame& F, int b, int h, int c) {
    const bf16_t* PROJ = (const bf16_t*)(F.ws + WS_PROJ); const bf16_t* QT = (const bf16_t*)(F.ws + WS_QT); const bf16_t* AT = (const bf16_t*)(F.ws + WS_AT);
    const bf16_t* VT = (const bf16_t*)(F.ws + WS_VT); const bf16_t* SST = (const bf16_t*)(F.ws + WS_SST);
    bf16_t* YM = (bf16_t*)(F.ws + WS_YMIX);
    LAS float* part = (LAS float*)F.lds;
    const int w = F.wave, lane = F.lane, l16 = lane & 15, q4 = lane >> 4, G = b * NCH + c;
    bf16x8 sb[2][4], vb[2][2];
#pragma unroll
    for (int vh = 0; vh < 2; ++vh) { const bf16_t* sp = SST + (((size_t)(G - 1) * 4 + h) * 256 + 32 * w + 16 * vh + l16) * 128 + 8 * q4;
        const bf16_t* vp = VT + ((size_t)G * 1024 + h * 256 + 32 * w + 16 * vh + l16) * 64 + 8 * q4;
#pragma unroll
        for (int s2 = 0; s2 < 4; ++s2) sb[vh][s2] = *(const bf16x8*)(sp + 32 * s2);
        vb[vh][0] = *(const bf16x8*)(vp); vb[vh][1] = *(const bf16x8*)(vp + 32); }
    unsigned short xg[4][4][2];
#pragma unroll
    for (int it = 0; it < 4; ++it)
#pragma unroll
        for (int r = 0; r < 4; ++r) { const size_t trow = (size_t)(b * SEQ + (c - 1) * 64 + 16 * it + 4 * q4 + r);
            xg[it][r][0] = PROJ[trow * INP + C_GO + h * 256 + 32 * w + l16]; xg[it][r][1] = PROJ[trow * INP + C_GO + h * 256 + 32 * w + 16 + l16]; }
    f32x4 oa[4][2];
#pragma unroll
    for (int it = 0; it < 4; ++it) { const bf16_t* qp = QT + ((size_t)G * 64 + 16 * it + l16) * 512 + h * 128 + 8 * q4; const bf16_t* ap = AT + (((size_t)G * 4 + h) * 64 + 16 * it + l16) * 64 + 8 * q4;
        const bf16x8 q0 = *(const bf16x8*)(qp), q1 = *(const bf16x8*)(qp + 32), q2 = *(const bf16x8*)(qp + 64), q3 = *(const bf16x8*)(qp + 96), a0 = *(const bf16x8*)(ap), a1 = *(const bf16x8*)(ap + 32);
#pragma unroll
        for (int vh = 0; vh < 2; ++vh) { f32x4 a = {0.f, 0.f, 0.f, 0.f};
            a = __builtin_amdgcn_mfma_f32_16x16x32_bf16(q0, sb[vh][0], a, 0, 0, 0); a = __builtin_amdgcn_mfma_f32_16x16x32_bf16(q1, sb[vh][1], a, 0, 0, 0);
            a = __builtin_amdgcn_mfma_f32_16x16x32_bf16(q2, sb[vh][2], a, 0, 0, 0); a = __builtin_amdgcn_mfma_f32_16x16x32_bf16(q3, sb[vh][3], a, 0, 0, 0);
            a = __builtin_amdgcn_mfma_f32_16x16x32_bf16(a0, vb[vh][0], a, 0, 0, 0); a = __builtin_amdgcn_mfma_f32_16x16x32_bf16(a1, vb[vh][1], a, 0, 0, 0);
            oa[it][vh] = a; } }
#pragma unroll
    for (int it = 0; it < 4; ++it)
#pragma unroll
        for (int r = 0; r < 4; ++r) { float ss = oa[it][0][r] * oa[it][0][r] + oa[it][1][r] * oa[it][1][r];
            ss += __shfl_xor(ss, 1); ss += __shfl_xor(ss, 2); ss += __shfl_xor(ss, 4); ss += __shfl_xor(ss, 8);
            if (l16 == 0) part[(16 * it + 4 * q4 + r) * 8 + w] = ss; }
    __syncthreads();
    const float g0 = F.in[I_GNG][32 * w + l16], g1 = F.in[I_GNG][32 * w + 16 + l16];
#pragma unroll
    for (int it = 0; it < 4; ++it)
#pragma unroll
        for (int r = 0; r < 4; ++r) { const int i = 16 * it + 4 * q4 + r;
            const f32x4 p0 = *(const LAS f32x4*)(part + i * 8), p1 = *(const LAS f32x4*)(part + i * 8 + 4);
            const float rstd = 1.f / sqrtf(((p0.x + p0.y) + (p0.z + p0.w) + (p1.x + p1.y) + (p1.z + p1.w)) * (1.f / 256.f) + LN_EPS);
            const size_t trow = (size_t)(b * SEQ + (c - 1) * 64 + i);
            const float x0 = bf2f(xg[it][r][0]), x1 = bf2f(xg[it][r][1]);
            const float y0 = oa[it][0][r] * rstd * g0 * (x0 / (1.f + __expf(-x0))), y1 = oa[it][1][r] * rstd * g1 * (x1 / (1.f + __expf(-x1)));
            YM[trow * DM + 1024 + h * 256 + 32 * w + l16] = f2bf(y0); YM[trow * DM + 1024 + h * 256 + 32 * w + 16 + l16] = f2bf(y1); }
    __syncthreads();
}
__device__ __forceinline__ void gla_out_phase(Frame& F) {
    for (int u = blockIdx.x; u < NB * 4 * 32; u += F.G) gla_out_unit(F, u >> 7, (u >> 5) & 3, 1 + (u & 31));
}

__device__ __forceinline__ int f2key(float f) { const int b = __float_as_int(f); return b ^ ((b >> 31) & 0x7fffffff); }
__device__ __forceinline__ float key2f(int k) { return __int_as_float(k ^ ((k >> 31) & 0x7fffffff)); }
#define CEX(a, b) do { const int _t = max(a, b); b = min(a, b); a = _t; } while (0)
__device__ __forceinline__ void sort16_desc(int (&x)[16]) {
#pragma unroll
    for (int k = 2; k <= 16; k <<= 1)
#pragma unroll
        for (int j = k >> 1; j > 0; j >>= 1)
#pragma unroll
            for (int i = 0; i < 16; ++i) { const int l = i ^ j; if (l > i) { if ((i & k) == 0) CEX(x[i], x[l]); else CEX(x[l], x[i]); } }
}
__device__ __forceinline__ void merge16_desc(int (&a)[16], const int (&b)[16]) {
#pragma unroll
    for (int i = 0; i < 16; ++i) a[i] = max(a[i], b[15 - i]);
#pragma unroll
    for (int j = 8; j > 0; j >>= 1)
#pragma unroll
        for (int i = 0; i < 16; ++i) { const int l = i ^ j; if (l > i) CEX(a[i], a[l]); }
}
__device__ __forceinline__ void peer_topk_task(Frame& F, int t0, int h) {
    const bf16_t* QH = (const bf16_t*)(F.ws + WS_QH); const bf16_t* SKB = (const bf16_t*)(F.ws + WS_SKB);
    unsigned short* EIDX = (unsigned short*)(F.ws + WS_EIDX); float* GATE = (float*)(F.ws + WS_GATE);
    const int lane = F.lane, r32 = lane & 31, hi = lane >> 5;
    int L1[16], L2[16];
#pragma unroll
    for (int c = 0; c < 2; ++c) {
        f32x16 acc[4] = {};
        const bf16_t* qp = QH + (size_t)(t0 + r32) * DM + (h * 2 + c) * 128 + 8 * hi;
        const bf16_t* kp = SKB + ((size_t)(h * 2 + c) * 128 + r32) * 128 + 8 * hi;
#pragma unroll
        for (int s = 0; s < 8; ++s) { const bf16x8 bq = *(const bf16x8*)(qp + 16 * s);
#pragma unroll
            for (int nt = 0; nt < 4; ++nt) acc[nt] = __builtin_amdgcn_mfma_f32_32x32x16_bf16(*(const bf16x8*)(kp + (size_t)nt * 32 * 128 + 16 * s), bq, acc[nt], 0, 0, 0); }
        int L[16], M[16];
#pragma unroll
        for (int nt = 0; nt < 4; ++nt) {
#pragma unroll
            for (int r = 0; r < 16; ++r) { const int n = 32 * nt + (r & 3) + 8 * (r >> 2) + 4 * hi; M[r] = (f2key(acc[nt][r]) & ~127) | n; }
            sort16_desc(M);
            if (nt == 0) {
#pragma unroll
                for (int i = 0; i < 16; ++i) L[i] = M[i];
            } else merge16_desc(L, M);
        }
#pragma unroll
        for (int i = 0; i < 16; ++i) M[i] = __shfl_xor(L[i], 32);
        merge16_desc(L, M);
#pragma unroll
        for (int i = 0; i < 16; ++i) { if (c == 0) L1[i] = L[i]; else L2[i] = L[i]; }
    }
    int Lc[16], M[16]; int nm = 0;
#pragma unroll
    for (int j = 0; j < 16; ++j) { const float sm = key2f(L1[0] & ~127) + key2f(L2[j] & ~127); Lc[j] = (f2key(sm) & ~16383) | ((L1[0] & 127) << 7) | (L2[j] & 127); }
#pragma unroll
    for (int i = 1; i < 16; ++i)
#pragma unroll
        for (int j = 0; j < 16; ++j) if ((i + 1) * (j + 1) <= 16) { const float sm = key2f(L1[i] & ~127) + key2f(L2[j] & ~127);
            M[nm & 15] = (f2key(sm) & ~16383) | ((L1[i] & 127) << 7) | (L2[j] & 127); ++nm;
            if ((nm & 15) == 0) { sort16_desc(M); merge16_desc(Lc, M); } }
    { M[2] = M[3] = M[4] = M[5] = M[6] = M[7] = M[8] = M[9] = M[10] = M[11] = M[12] = M[13] = M[14] = M[15] = (int)0x80000000;
      if (M[0] < M[1]) { const int t_ = M[0]; M[0] = M[1]; M[1] = t_; }
      merge16_desc(Lc, M); }
    float ev[16]; float esum = 0.f; const float vmax = key2f(Lc[0] & ~16383);
#pragma unroll
    for (int k = 0; k < 16; ++k) { ev[k] = __expf(key2f(Lc[k] & ~16383) - vmax); esum += ev[k]; }
    const float rs = 1.f / esum;
    const size_t t = (size_t)(t0 + r32);
#pragma unroll
    for (int k = 0; k < 16; ++k) if ((k >> 3) == hi) { EIDX[t * 128 + h * 16 + k] = (unsigned short)(Lc[k] & 16383); GATE[t * 128 + h * 16 + k] = ev[k] * rs; }
}
__device__ __forceinline__ void peer_topk_phase(Frame& F) {
    for (int u = F.gw; u < (T / 32) * 8; u += F.ngw) peer_topk_task(F, (u >> 3) * 32, u & 7);
}

__device__ __forceinline__ void peer_scatter_phase(Frame& F) {
    const unsigned short* EIDX = (const unsigned short*)(F.ws + WS_EIDX); const float* GATE = (const float*)(F.ws + WS_GATE); unsigned* PBM = (unsigned*)(F.ws + WS_PBM);
    unsigned char* C8 = F.ws + WS_C; const int lane = F.lane;
    for (int r = F.gw; r < T; r += F.ngw) {
        unsigned char* crow = C8 + (size_t)r * NEXP; const size_t t = (size_t)r;
        const int e0 = EIDX[t * 128 + lane], e1 = EIDX[t * 128 + 64 + lane]; const float g0 = GATE[t * 128 + lane], g1 = GATE[t * 128 + 64 + lane];
        float tot0 = 0.f, tot1 = 0.f;
        for (int k = 0; k < 64; ++k) { const int ek = __builtin_amdgcn_readlane(e0, k); const float gk = __uint_as_float(__builtin_amdgcn_readlane(__float_as_uint(g0), k));
            tot0 += (e0 == ek) ? gk : 0.f; tot1 += (e1 == ek) ? gk : 0.f; }
        for (int k = 0; k < 64; ++k) { const int ek = __builtin_amdgcn_readlane(e1, k); const float gk = __uint_as_float(__builtin_amdgcn_readlane(__float_as_uint(g1), k));
            tot0 += (e0 == ek) ? gk : 0.f; tot1 += (e1 == ek) ? gk : 0.f; }
        crow[e0] = (unsigned char)(__builtin_amdgcn_cvt_pk_fp8_f32(tot0 * 256.f, 0.f, 0, false) & 255); crow[e1] = (unsigned char)(__builtin_amdgcn_cvt_pk_fp8_f32(tot1 * 256.f, 0.f, 0, false) & 255);
        atomicOr(PBM + t * 512 + (e0 >> 5), 1u << (e0 & 31)); atomicOr(PBM + t * 512 + (e1 >> 5), 1u << (e1 & 31));
    }
}

struct Args { const float* in[20]; float* out; unsigned char* ws; int ph_lo, ph_hi; };
constexpr int N_PHASES = 16;
__global__ void __launch_bounds__(NTHREADS, 2) mk_fwd(Args args) {
    extern __shared__ __attribute__((aligned(16))) unsigned char lds_raw[];
    Frame F;
    F.lds = (LAS unsigned char*)lds_raw;
    F.tid = threadIdx.x; F.lane = F.tid & 63; F.wave = __builtin_amdgcn_readfirstlane(F.tid >> 6);
    F.G = gridDim.x; F.gw = blockIdx.x * NWAVES + F.wave; F.ngw = F.G * NWAVES;
#pragma unroll
    for (int i = 0; i < 20; ++i) F.in[i] = args.in[i];
    F.out = args.out; F.ws = args.ws;
    volatile LAS unsigned* lctl = (volatile LAS unsigned*)(F.lds + LDSCTL_OFF);
    if (F.tid < 64) lctl[F.tid] = 0u;
    __syncthreads();
    unsigned* ctl = (unsigned*)(F.ws + WS_CTL);
    const int lo = args.ph_lo, hi = args.ph_hi;
    XcdBarrier bar; bar.bar = ctl + 1024; bar.x = 0; bar.st = lctl + 8;
    if (hi - lo > 1) bar = xcd_barrier_post(ctl + 1024, lctl + 8);
#define IN(k) (lo <= (k) && (k) < hi)
#define SEAM(k) do { if (IN(k) && IN((k) + 1)) xcd_barrier(bar); } while (0)
#define LOCAL(k) do { if (IN(k) && IN((k) + 1)) __syncthreads(); } while (0)
    const int bid = blockIdx.x;
#define REFRESH() do { int t_ = threadIdx.x; asm volatile("" : "+v"(t_)); F.tid = t_; F.lane = t_ & 63; } while (0)

    if (IN(0)) { REFRESH(); p0_prologue(F); } SEAM(0);
    if (IN(1)) { REFRESH();
        pg8::Gemm g{(const bf16_t*)(F.ws + WS_H0), (const bf16_t*)(F.ws + WS_WIN), TM, INP, DM, DM, DM}; pg8::StaticOrder S; S.init(TM, INP, F.G, bid);
        pg8::EpiBf16 E{(bf16_t*)(F.ws + WS_PROJ), INP, 1.f};
        pg8::gemm_phase<pg8::EpiBf16, true>(F.lds, g, S, E);
    } SEAM(1);
    if (IN(2)) { REFRESH();
        kv_meta(F);
        pg8::Gemm g{(const bf16_t*)(F.ws + WS_PROJ) + C_CKV, (const bf16_t*)(F.ws + WS_WKV), T, 2048, 256, INP, 256}; pg8::StaticOrder S; S.init(T, 2048, F.G, bid);
        pg8::EpiBf16 E{(bf16_t*)(F.ws + WS_KVP), 2048, 1.f};
        pg8::gemm_phase<pg8::EpiBf16, true>(F.lds, g, S, E);
    } LOCAL(2);
    if (IN(3)) { REFRESH(); idx_phase(F); } LOCAL(3);
    if (IN(4)) { REFRESH(); gla_prep_phase(F); } SEAM(4);
    if (IN(5)) { REFRESH(); gla_scan_phase(F); } LOCAL(5);
    if (IN(6)) { REFRESH(); att::attn_phase(F); } SEAM(6);
    if (IN(7)) { REFRESH(); gla_out_phase(F); } SEAM(7);
    if (IN(8)) { REFRESH();
        pg8::Gemm g{(const bf16_t*)(F.ws + WS_YMIX), (const bf16_t*)(F.ws + WS_WO), T, DM, DM, DM, DM}; pg8::StaticOrder S; S.init(T, DM, F.G, bid);
        pg8::EpiResLn0 E{F.out, DM, F.in[I_X], (const float*)(F.ws + WS_ST0), F.in[I_LN0G], F.in[I_LN0B], ALPHA};
        pg8::gemm_phase<pg8::EpiResLn0, true>(F.lds, g, S, E);
    } SEAM(8);
    if (IN(9)) { REFRESH();
        bf16_t* H1 = (bf16_t*)(F.ws + WS_H1); unsigned* H1F8 = (unsigned*)(F.ws + WS_H1F8);
        for (int m = F.gw; m < T; m += F.ngw) ln_row_to_bf16(F.out + (size_t)m * DM, F.in[I_LN1G], F.in[I_LN1B], H1 + (size_t)m * DM, F.lane, H1F8 + (size_t)m * (DM / 4));
        convert_f32_f8(F.in[I_UTAB], F.ws + WS_UF8, pg8::PEER_SU, (size_t)NEXP * DM / 8, (size_t)F.gw * 64 + F.lane, (size_t)F.ngw * 64);
        { LAS float* scr = (LAS float*)(F.lds + F.wave * 8704);
          for (int it = F.gw; it < (NEXP / 64) * (DM / 32); it += F.ngw) transpose_item_f8(F.in[I_VTAB], DM, F.ws + WS_VF8, NEXP, pg8::PEER_SV, scr, it, F.lane); }
        { u32x4* z = (u32x4*)(F.ws + WS_PBM); const size_t n = (size_t)T * 2048 / 16;
          for (size_t i = (size_t)F.gw * 64 + F.lane; i < n; i += (size_t)F.ngw * 64) z[i] = (u32x4){0u, 0u, 0u, 0u}; }
    } SEAM(9);
    if (IN(10)) { REFRESH();
        pg8::Gemm g{(const bf16_t*)(F.ws + WS_H1), (const bf16_t*)(F.ws + WS_WPQ), T, DM, DM, DM, DM}; pg8::StaticOrder S; S.init(T, DM, F.G, bid);
        pg8::EpiBf16 E{(bf16_t*)(F.ws + WS_QH), DM, 1.f};
        pg8::gemm_phase<pg8::EpiBf16, true>(F.lds, g, S, E);
    } SEAM(10);
    if (IN(11)) { REFRESH(); peer_topk_phase(F); } SEAM(11);
    if (IN(12)) { REFRESH(); peer_scatter_phase(F); } SEAM(12);
    if (IN(13)) { REFRESH();
        pg8::Gemm g{(const bf16_t*)(F.ws + WS_H1F8), (const bf16_t*)(F.ws + WS_UF8), T, NEXP, DM / 2, DM / 2, DM / 2}; pg8::StaticOrder S; S.init(T, NEXP, F.G, bid);
        pg8::EpiPeer E{F.ws + WS_C, NEXP, (const unsigned char*)(F.ws + WS_PBM), 1.f / pg8::PEER_SU};
        pg8::gemm_phase<pg8::EpiPeer, true, true>(F.lds, g, S, E);
    } SEAM(13);
    if (IN(14)) { REFRESH();
        pg8::Gemm g{(const bf16_t*)(F.ws + WS_C), (const bf16_t*)(F.ws + WS_VF8), T, DM, NEXP / 2, NEXP / 2, NEXP / 2}; pg8::StaticOrder S; S.init(T, DM, F.G, bid);
        pg8::EpiResF32 E{F.out, DM, (const bf16_t*)(F.ws + WS_H1), DM, ALPHA, 1.f / (pg8::PEER_SC * pg8::PEER_SV)};
        pg8::gemm_phase<pg8::EpiResF32, true, true>(F.lds, g, S, E);
    } SEAM(14);
    if (IN(15)) { REFRESH(); for (int m = F.gw; m < T; m += F.ngw) ln_row_to_f32(F.out + (size_t)m * DM, F.in[I_LN2G], F.in[I_LN2B], F.out + (size_t)m * DM, F.lane); }
#undef LOCAL
#undef REFRESH
#undef IN
#undef SEAM
}

#ifndef MK_TAILSEQ
#define MK_TAILSEQ {-1}
#endif
#ifndef MK_REPS
#define MK_REPS {1,1,1,1,1,1,1,1,1,1,1,1,1,1,1,1}
#endif
#ifndef MK_ONE_LAUNCH
#define MK_ONE_LAUNCH 1
#endif
extern "C" void kernel_launch(void* const* d_in, const int* in_sizes, int n_in, void* d_out, int out_size, void* d_ws, size_t ws_size, hipStream_t stream) {
    static int grid = 0;
    if (grid == 0) {
        if (n_in != 20 || out_size != T * DM || ws_size < WS_END) { fprintf(stderr, "kernel_launch: shape mismatch n_in %d out %d ws %zu (need %zu)\n", n_in, out_size, ws_size, (size_t)WS_END); grid = -1; return; }
        int dev = 0, cus = 0, per_cu = 0;
        if (hipGetDevice(&dev) != hipSuccess || hipDeviceGetAttribute(&cus, hipDeviceAttributeMultiprocessorCount, dev) != hipSuccess) { grid = -1; return; }
        if (hipFuncSetAttribute((const void*)mk_fwd, hipFuncAttributeMaxDynamicSharedMemorySize, LDS_BYTES) != hipSuccess) { fprintf(stderr, "kernel_launch: hipFuncSetAttribute failed\n"); grid = -1; return; }
        if (hipOccupancyMaxActiveBlocksPerMultiprocessor(&per_cu, (const void*)mk_fwd, NTHREADS, LDS_BYTES) != hipSuccess || per_cu < 1) fprintf(stderr, "kernel_launch: occupancy query says %d\n", per_cu);
        (void)hipGetLastError();
        grid = cus;
    }
    if (grid < 0) return;
    (void)hipMemsetAsync((char*)d_ws + WS_CTL, 0, CTL_ZERO_BYTES, stream);
    Args a{};
    for (int i = 0; i < 20; ++i) a.in[i] = (const float*)d_in[i];
    a.out = (float*)d_out; a.ws = (unsigned char*)d_ws;
#if MK_ONE_LAUNCH
    a.ph_lo = 0; a.ph_hi = N_PHASES;
    hipLaunchKernelGGL(mk_fwd, dim3(grid), dim3(NTHREADS), LDS_BYTES, stream, a);
#else
    static const int reps[N_PHASES] = MK_REPS; static const int tailseq[] = MK_TAILSEQ;
    for (int p = 0; p < N_PHASES; ++p) for (int r = 0; r < reps[p]; ++r) { a.ph_lo = p; a.ph_hi = p + 1; hipLaunchKernelGGL(mk_fwd, dim3(grid), dim3(NTHREADS), LDS_BYTES, stream, a); }
    for (unsigned i = 0; i < sizeof(tailseq) / sizeof(int); ++i) if (tailseq[i] >= 0) { a.ph_lo = tailseq[i]; a.ph_hi = tailseq[i] + 1; hipLaunchKernelGGL(mk_fwd, dim3(grid), dim3(NTHREADS), LDS_BYTES, stream, a); }
#endif
}
```

```cpp
#include <hip/hip_runtime.h>
#include <cstdio>
#include <cstdint>

#define LAS __attribute__((address_space(3)))
#define GAS __attribute__((address_space(1)))
typedef unsigned short bf16_t;
typedef short bf16x8 __attribute__((ext_vector_type(8)));
typedef short s16x4 __attribute__((ext_vector_type(4)));
typedef float f32x2 __attribute__((ext_vector_type(2)));
typedef float f32x4 __attribute__((ext_vector_type(4)));
typedef float f32x16 __attribute__((ext_vector_type(16)));
typedef unsigned u32x2 __attribute__((ext_vector_type(2)));
typedef unsigned u32x4 __attribute__((ext_vector_type(4)));

constexpr int DM = 2048, NB = 8, SEQ = 2048, NMETA = 16, T = NB * SEQ, TM = T + 256;
constexpr int INC = 5472, INP = 5632;
constexpr int C_AQ = 0, C_CKV = 1024, C_IQ = 1280, C_IK = 2304, C_IW = 2368, C_GQ = 2384, C_GK = 2896, C_GV = 3408, C_GR = 4432, C_GO = 4448;
constexpr int NEXP = 16384;
constexpr float LN_EPS = 1e-5f, ALPHA = 1.189207115002721f, LOG2E = 1.4426950408889634f;
constexpr int NCH = 33;
constexpr int PCH = 8192;

constexpr size_t MiB = 1u << 20;
constexpr size_t WS_CTL = 0, CTL_ZERO_BYTES = 64 * 1024;
constexpr size_t WS_BT = 64 * 1024;
constexpr size_t WS_SKB = 256 * 1024;
constexpr size_t WS_WKV = 1 * MiB;
constexpr size_t WS_EB = 2 * MiB;
constexpr size_t WS_GSS = 3 * MiB;
constexpr size_t WS_H0 = 8 * MiB;
constexpr size_t WS_WIN = 73 * MiB;
constexpr size_t WS_SST = 8 * MiB;
constexpr size_t WS_QT = 74 * MiB;
constexpr size_t WS_AT = 90 * MiB + 512 * 1024;
constexpr size_t WS_ST0 = 7 * MiB;
constexpr size_t WS_PROJ = 99 * MiB;
constexpr size_t WS_KVP = 278 * MiB;
constexpr size_t WS_BM = 343 * MiB;
constexpr size_t WS_KTT = 348 * MiB;
constexpr size_t WS_VT = 365 * MiB;
constexpr size_t WS_GLAO = 398 * MiB;
constexpr size_t WS_YMIX = 430 * MiB;
constexpr size_t WS_WPQ = 496 * MiB;
constexpr size_t WS_WO = 504 * MiB;
constexpr size_t WS_H1 = 8 * MiB;
constexpr size_t WS_UF8 = 72 * MiB;
constexpr size_t WS_VF8 = 104 * MiB;
constexpr size_t WS_H1F8 = 136 * MiB;
constexpr size_t WS_EIDX = 168 * MiB;
constexpr size_t WS_GATE = 172 * MiB;
constexpr size_t WS_PBM = 212 * MiB;
constexpr size_t WS_C = 244 * MiB;
constexpr size_t WS_QH = 180 * MiB;
constexpr size_t WS_END = 512 * MiB;
static_assert(WS_C + (size_t)T * NEXP <= WS_WO, "C vs WoT");

constexpr int RING_BYTES = 135168;
constexpr int LDSCTL_OFF = 139264;
constexpr int LDS_BYTES = 147456;
constexpr int NWAVES = 8, NTHREADS = 512;

#define LDS_WAIT() asm volatile("s_waitcnt lgkmcnt(0)" ::: "memory")
#define VM_WAIT() asm volatile("s_waitcnt vmcnt(0)" ::: "memory")
#define SBAR() __builtin_amdgcn_sched_barrier(0)

typedef __bf16 bf16x2_t __attribute__((ext_vector_type(2)));
__device__ __forceinline__ unsigned cvtpk(float lo, float hi) { const f32x2 v = {lo, hi}; return __builtin_bit_cast(unsigned, __builtin_convertvector(v, bf16x2_t)); }
__device__ __forceinline__ bf16_t f2bf(float f) { return (bf16_t)(cvtpk(f, 0.f) & 0xffffu); }
__device__ __forceinline__ float bf2f(unsigned short b) { return __uint_as_float(((unsigned)b) << 16); }
__device__ __forceinline__ float bflo(unsigned w) { return __uint_as_float(w << 16); }
__device__ __forceinline__ float bfhi(unsigned w) { return __uint_as_float(w & 0xffff0000u); }
__device__ __forceinline__ float wave_sum(float v) {
#pragma unroll
    for (int o = 1; o < 64; o <<= 1) v += __shfl_xor(v, o);
    return v;
}
__device__ __forceinline__ int crow(int r, int hi) { return (r & 3) + 8 * (r >> 2) + 4 * hi; }

#define XB_TMO      128
#define XB_XCNT(j)  (256  + 64 * (j))
#define XB_XSUB(j)  (1280 + 64 * (j))
#define XB_XGEN(j)  (2304 + 64 * (j))
#define XB_TOP      3328
#define XB_TOPGEN   3392
#define XCD_BAR_WORDS 3456
#define XB_SPIN_CAP (1u << 18)
__device__ __forceinline__ unsigned xb_ld(unsigned* p)              { return __hip_atomic_load(p, __ATOMIC_RELAXED, __HIP_MEMORY_SCOPE_AGENT); }
__device__ __forceinline__ unsigned xb_add(unsigned* p, unsigned v) { return __hip_atomic_fetch_add(p, v, __ATOMIC_RELAXED, __HIP_MEMORY_SCOPE_AGENT); }
__device__ __forceinline__ unsigned xb_xcc_id() { return (unsigned)__builtin_amdgcn_s_getreg((3 << 11) | 20) & 0xFu; }
#define XB_SPIN(cond, bar) do { unsigned _sp = 0; while (cond) { __builtin_amdgcn_s_sleep(1); \
    if ((++_sp & 255u) == 0u) { if (xb_ld(&(bar)[XB_TMO])) break; if (_sp > XB_SPIN_CAP) { atomicAdd(&(bar)[XB_TMO], 1u); break; } } } } while (0)
struct XcdBarrier { unsigned* bar; unsigned x; volatile LAS unsigned* st; };
__device__ __forceinline__ XcdBarrier xcd_barrier_post(unsigned* bar, volatile LAS unsigned* st) {
    XcdBarrier b; b.bar = bar; b.x = xb_xcc_id(); b.st = st;
    if (threadIdx.x == 0) (void)xb_add(&bar[XB_XCNT(b.x)], 1u);
    return b;
}
__device__ __forceinline__ void xcd_barrier_complete(unsigned* bar, unsigned x, unsigned& nloc, unsigned& nx) {
    const unsigned G = gridDim.x * gridDim.y * gridDim.z;
    unsigned sum, cnt, mine, sp = 0u;
    for (;;) {
        sum = 0u; cnt = 0u; mine = 0u;
#pragma unroll
        for (unsigned j = 0; j < 16; ++j) { const unsigned c = xb_ld(&bar[XB_XCNT(j)]); sum += c; cnt += (c > 0u) ? 1u : 0u; mine = (j == x) ? c : mine; }
        if (sum == G) break;
        __builtin_amdgcn_s_sleep(1);
        if ((++sp & 255u) == 0u) { if (xb_ld(&bar[XB_TMO])) break; if (sp > XB_SPIN_CAP) { atomicAdd(&bar[XB_TMO], 1u); break; } }
    }
    nloc = mine > 0u ? mine : 1u; nx = cnt > 0u ? cnt : 1u;
}
__device__ __forceinline__ void xcd_barrier(const XcdBarrier& b) {
    asm volatile("s_waitcnt vmcnt(0)" ::: "memory");
    __syncthreads();
    if (threadIdx.x == 0) {
        unsigned* bar = b.bar;
        __builtin_amdgcn_s_waitcnt(0);
        unsigned nloc = b.st[0], nx = b.st[1];
        if (nloc == 0u) { xcd_barrier_complete(bar, b.x, nloc, nx); b.st[0] = nloc; b.st[1] = nx; }
        const unsigned old = xb_add(&bar[XB_XSUB(b.x)], 1u);
        const unsigned gen = old / nloc;
        if (old + 1u == (gen + 1u) * nloc) {
            __builtin_amdgcn_fence(__ATOMIC_RELEASE, "agent");
            asm volatile("s_waitcnt vmcnt(0)" ::: "memory");
            const unsigned og = xb_add(&bar[XB_TOP], 1u);
            const unsigned tg = og / nx;
            if (og + 1u == (tg + 1u) * nx) xb_add(&bar[XB_TOPGEN], 1u);
            else XB_SPIN(xb_ld(&bar[XB_TOPGEN]) == tg, bar);
            __builtin_amdgcn_fence(__ATOMIC_ACQUIRE, "agent");
            xb_add(&bar[XB_XGEN(b.x)], 1u);
            asm volatile("s_waitcnt vmcnt(0)" ::: "memory");
        } else {
            XB_SPIN(xb_ld(&bar[XB_XGEN(b.x)]) == gen, bar);
            __builtin_amdgcn_fence(__ATOMIC_ACQUIRE, "agent");
            asm volatile("s_waitcnt vmcnt(0)" ::: "memory");
        }
    }
    __syncthreads();
}

namespace pg8 {
constexpr int BM = 256, BK = 64, HALF = 128, HTB = HALF * BK * 2, STAGE_BYTES = 8 * HTB, NXCD = 8, WGM = 8;
__host__ __device__ __forceinline__ int lds_byte(int r, int c) { const int st = (r >> 4) * 2 + (c >> 5), rr = r & 15, cc = c & 31, ob = rr * 64 + cc * 2; return st * 1024 + (ob ^ (((ob >> 9) & 1) << 5)); }
__host__ __device__ __forceinline__ void stage_rc(int b, int& R, int& C) { const int st = b / 1024, sb = b % 1024, swz = sb ^ (((sb >> 9) & 1) << 5); R = (st >> 1) * 16 + swz / 64; C = (st & 1) * 32 + (swz % 64) / 2; }
__host__ __device__ __forceinline__ int perm32(int rho) { const int n = rho >> 4, i = rho & 15; return 8 * (i >> 2) + 4 * n + (i & 3); }
struct Unit { int pm, pn; };
struct Gemm { const bf16_t* A; const bf16_t* Bt; int M, N, K, lda, ldb; };
struct StaticOrder {
    int nM, nN, nwg, G, c;
    __host__ __device__ void init(int M, int N, int G_, int c_) { nM = M / BM; nN = N / BM; nwg = nM * nN; G = G_; c = c_; }
    __host__ __device__ bool next(int i, Unit& u) const {
        const long L = (long)i * G + c; if (L >= nwg) return false;
        int wgid = (int)L; { const int q = nwg / NXCD, r = nwg % NXCD, xcd = wgid % NXCD, off = wgid / NXCD; wgid = (xcd < r ? xcd * (q + 1) : r * (q + 1) + (xcd - r) * q) + off; }
        const int nig = WGM * nN, gid = wgid / nig, fm = gid * WGM, gsz = (nM - fm) < WGM ? (nM - fm) : WGM;
        u.pm = fm + ((wgid % nig) % gsz); u.pn = (wgid % nig) / gsz; return true;
    }
};
struct EpiBf16 {
    static constexpr bool PERM = true;
    bf16_t* O; int ldc; float sc;
    __device__ __forceinline__ void operator()(const f32x4 (&acc)[2][2][4][2], const Unit& u, int wr, int wc, int fr, int fq) const {
        const int row0 = u.pm * BM + wr * 64 + fr, col0 = u.pn * BM + wc * 32 + 8 * fq;
#pragma unroll
        for (int ai = 0; ai < 2; ++ai)
#pragma unroll
            for (int m = 0; m < 4; ++m) { bf16_t* rowp = O + (size_t)(row0 + ai * HALF + m * 16) * ldc + col0;
#pragma unroll
                for (int bj = 0; bj < 2; ++bj) { const f32x4 v0 = acc[ai][bj][m][0] * sc, v1 = acc[ai][bj][m][1] * sc;
                    u32x4 w; w.x = cvtpk(v0[0], v0[1]); w.y = cvtpk(v0[2], v0[3]); w.z = cvtpk(v1[0], v1[1]); w.w = cvtpk(v1[2], v1[3]);
                    *(u32x4*)(rowp + bj * HALF) = w; } }
    }
};
struct EpiResF32 {
    static constexpr bool PERM = false;
    float* out; int ldc; const bf16_t* base; int ldbase; float alpha; float sc;
    __device__ __forceinline__ void operator()(const f32x4 (&acc)[2][2][4][2], const Unit& u, int wr, int wc, int fr, int fq) const {
        const int row0 = u.pm * BM + wr * 64 + fr, col0 = u.pn * BM + wc * 32 + 4 * fq;
#pragma unroll
        for (int ai = 0; ai < 2; ++ai)
#pragma unroll
            for (int m = 0; m < 4; ++m) { const size_t row = (size_t)(row0 + ai * HALF + m * 16);
#pragma unroll
                for (int bj = 0; bj < 2; ++bj)
#pragma unroll
                    for (int n = 0; n < 2; ++n) { const int c = col0 + bj * HALF + n * 16;
                        const u32x2 bw = *(const u32x2*)(base + row * ldbase + c);
                        f32x4 o = acc[ai][bj][m][n] * sc;
                        o[0] += alpha * bflo(bw.x); o[1] += alpha * bfhi(bw.x); o[2] += alpha * bflo(bw.y); o[3] += alpha * bfhi(bw.y);
                        *(f32x4*)(out + row * ldc + c) = o; } }
    }
};
struct EpiResLn0 {
    static constexpr bool PERM = false;
    float* out; int ldc; const float* x; const float* st; const float* g; const float* b; float alpha;
    __device__ __forceinline__ void operator()(const f32x4 (&acc)[2][2][4][2], const Unit& u, int wr, int wc, int fr, int fq) const {
        const int row0 = u.pm * BM + wr * 64 + fr, col0 = u.pn * BM + wc * 32 + 4 * fq;
        f32x4 gg[2][2], bb[2][2];
#pragma unroll
        for (int bj = 0; bj < 2; ++bj)
#pragma unroll
            for (int n = 0; n < 2; ++n) { gg[bj][n] = *(const f32x4*)(g + col0 + bj * HALF + n * 16) * alpha; bb[bj][n] = *(const f32x4*)(b + col0 + bj * HALF + n * 16) * alpha; }
#pragma unroll
        for (int ai = 0; ai < 2; ++ai)
#pragma unroll
            for (int m = 0; m < 4; ++m) { const size_t row = (size_t)(row0 + ai * HALF + m * 16); const f32x2 ms = *(const f32x2*)(st + 2 * row);
#pragma unroll
                for (int bj = 0; bj < 2; ++bj)
#pragma unroll
                    for (int n = 0; n < 2; ++n) { const int c = col0 + bj * HALF + n * 16;
                        const f32x4 xv = *(const f32x4*)(x + row * ldc + c);
                        *(f32x4*)(out + row * ldc + c) = acc[ai][bj][m][n] + ((xv - ms.x) * ms.y) * gg[bj][n] + bb[bj][n]; } }
    }
};
__device__ __forceinline__ float gelu_exact(float v) {
    const float av = fabsf(v), t = __builtin_amdgcn_rcpf(av * 0.2316418882f + 1.0f);
    float q = t * 0.5307027145f + (-0.7265760135f); q = q * t + 0.7107068705f; q = q * t + (-0.142248368f); q = q * t + 0.127414796f; q = q * t;
    const float e = __builtin_amdgcn_exp2f((v * v) * (-0.72134752044f));
    const float m = v * (q * e);
    return v < 0.f ? m : v - m;
}
constexpr float PEER_SU = 64.f, PEER_SV = 8.f, PEER_SC = 64.f, PEER_SA = 32.f;
struct EpiF8 {
    static constexpr bool PERM = true;
    unsigned char* O; int ldc; float sc;
    __device__ __forceinline__ void operator()(const f32x4 (&acc)[2][2][4][2], const Unit& u, int wr, int wc, int fr, int fq) const {
        const int row0 = u.pm * BM + wr * 64 + fr, col0 = u.pn * BM + wc * 32 + 8 * fq;
#pragma unroll
        for (int ai = 0; ai < 2; ++ai)
#pragma unroll
            for (int m = 0; m < 4; ++m) { unsigned char* rowp = O + (size_t)(row0 + ai * HALF + m * 16) * ldc + col0;
#pragma unroll
                for (int bj = 0; bj < 2; ++bj) { const f32x4 v0 = acc[ai][bj][m][0] * sc, v1 = acc[ai][bj][m][1] * sc;
                    int w0 = 0, w1 = 0;
                    w0 = __builtin_amdgcn_cvt_pk_fp8_f32(v0[0], v0[1], w0, false); w0 = __builtin_amdgcn_cvt_pk_fp8_f32(v0[2], v0[3], w0, true);
                    w1 = __builtin_amdgcn_cvt_pk_fp8_f32(v1[0], v1[1], w1, false); w1 = __builtin_amdgcn_cvt_pk_fp8_f32(v1[2], v1[3], w1, true);
                    *(u32x2*)(rowp + bj * HALF) = (u32x2){(unsigned)w0, (unsigned)w1}; } }
    }
};

typedef int v8i_t __attribute__((ext_vector_type(8)));
typedef int v4i_t __attribute__((ext_vector_type(4)));
template <class Epi, bool ALIGN_EPI, bool F8 = false>
__device__ __forceinline__ void gemm_phase(LAS unsigned char* lds, const Gemm g, const StaticOrder& S, const Epi& E) {
    const int tid = threadIdx.x, wid = __builtin_amdgcn_readfirstlane(tid >> 6), lane = tid & 63, wr = wid >> 2, wc = wid & 3, fr = lane & 15, fq = lane >> 4;
    const int K = g.K, nt = K / BK;
    unsigned voffA[2], voffB[2];
#pragma unroll
    for (int i = 0; i < 2; ++i) { int R, C; stage_rc(tid * 16 + i * 8192, R, C); const int Rb = Epi::PERM ? ((R & ~31) + perm32(R & 31)) : R;
        voffA[i] = (unsigned)(R * g.lda + C) * 2u; voffB[i] = (unsigned)(Rb * g.ldb + C) * 2u; }
    const size_t kstep = (size_t)(BK * 2);
    const size_t hstepA = (size_t)HALF * g.lda * 2, hstepB = (size_t)HALF * g.ldb * 2;
    const size_t tstepA = 2 * hstepA, tstepB = 2 * hstepB;
    const unsigned ldsw = (unsigned)wid * 1024u;
    const int aoff = lds_byte(wr * 64 + fr, fq * 8), boff = lds_byte(wc * 32 + fr, fq * 8);
#define PG8_SA(b, h) (((b) * 2 + (h)) * HTB)
#define PG8_SB(b, h) ((4 + (b) * 2 + (h)) * HTB)
#define PG8_STAGE(bufoff, gbase, voff) do { _Pragma("unroll") for (int _i = 0; _i < 2; ++_i) \
        __builtin_amdgcn_global_load_lds((const unsigned*)((const char*)(gbase) + (voff)[_i]), (LAS unsigned*)(lds + (bufoff) + ldsw + _i * 8192), 16, 0, 0); } while (0)
#define PG8_LDA(dst, b, h) do { _Pragma("unroll") for (int m = 0; m < 4; ++m) _Pragma("unroll") for (int k = 0; k < 2; ++k) dst[m][k] = *(const LAS bf16x8*)(lds + PG8_SA(b, h) + aoff + m * 2048 + k * 1024); } while (0)
#define PG8_LDB(dst, b, h) do { _Pragma("unroll") for (int n = 0; n < 2; ++n) _Pragma("unroll") for (int k = 0; k < 2; ++k) dst[n][k] = *(const LAS bf16x8*)(lds + PG8_SB(b, h) + boff + n * 2048 + k * 1024); } while (0)
#define PG8_CAT(x) __builtin_shufflevector(__builtin_bit_cast(v4i_t, x[0]), __builtin_bit_cast(v4i_t, x[1]), 0, 1, 2, 3, 4, 5, 6, 7)
#define PG8_MMA(ai, bj, At, Bt) do { __builtin_amdgcn_s_setprio(1); \
        if constexpr (F8) { _Pragma("unroll") for (int m = 0; m < 4; ++m) _Pragma("unroll") for (int n = 0; n < 2; ++n) \
            asm volatile("v_mfma_scale_f32_16x16x128_f8f6f4 %0, %1, %2, %0, %3, %3 op_sel_hi:[0,0,0]" : "+v"(acc[ai][bj][m][n]) : "v"(PG8_CAT(Bt[n])), "v"(PG8_CAT(At[m])), "v"(f8one)); } \
        else { _Pragma("unroll") for (int m = 0; m < 4; ++m) _Pragma("unroll") for (int n = 0; n < 2; ++n) _Pragma("unroll") for (int k = 0; k < 2; ++k) \
            acc[ai][bj][m][n] = __builtin_amdgcn_mfma_f32_16x16x32_bf16(Bt[n][k], At[m][k], acc[ai][bj][m][n], 0, 0, 0); } \
        __builtin_amdgcn_s_setprio(0); } while (0)
#define PG8_WAIT_V(n) asm volatile("s_waitcnt vmcnt(" #n ")" ::: "memory")
#define PG8_WAIT_L(n) asm volatile("s_waitcnt lgkmcnt(" #n ")" ::: "memory")
#define PG8_BAR __builtin_amdgcn_s_barrier()
#define PG8_SCHED __builtin_amdgcn_sched_barrier(0)
    Unit cur, nxt; int ui = 0;
    if (!S.next(0, cur)) return;
    const int f8one = 127;
    f32x4 acc[2][2][4][2];
#pragma unroll
    for (int a = 0; a < 2; ++a)
#pragma unroll
        for (int b = 0; b < 2; ++b)
#pragma unroll
            for (int m = 0; m < 4; ++m)
#pragma unroll
                for (int n = 0; n < 2; ++n) acc[a][b][m][n] = (f32x4){0.f, 0.f, 0.f, 0.f};
    bf16x8 At[4][2], B0[2][2], B1[2][2];
    const char* cA = (const char*)g.A + (size_t)cur.pm * tstepA; const char* cB = (const char*)g.Bt + (size_t)cur.pn * tstepB;
    PG8_STAGE(PG8_SB(0, 0), cB, voffB); PG8_STAGE(PG8_SB(0, 1), cB + hstepB, voffB); PG8_STAGE(PG8_SA(0, 0), cA, voffA); PG8_STAGE(PG8_SA(0, 1), cA + hstepA, voffA);
    if (wr == 1) PG8_BAR;
    PG8_WAIT_V(2); PG8_BAR;
    PG8_STAGE(PG8_SB(1, 0), cB + kstep, voffB); PG8_STAGE(PG8_SA(1, 0), cA + kstep, voffA); PG8_STAGE(PG8_SB(1, 1), cB + hstepB + kstep, voffB);
    PG8_WAIT_V(6); PG8_BAR;
    for (;;) {
        const bool has_next = S.next(ui + 1, nxt);
        const char* nA = has_next ? (const char*)g.A + (size_t)nxt.pm * tstepA : cA; const char* nB = has_next ? (const char*)g.Bt + (size_t)nxt.pn * tstepB : cB;
        for (int t = 0; t < nt; t += 2) {
            const bool last = (t == nt - 2);
            const char* a1 = cA + (size_t)(t + 1) * kstep;
            const char* a2 = last ? nA : cA + (size_t)(t + 2) * kstep; const char* b2 = last ? nB : cB + (size_t)(t + 2) * kstep;
            const char* a3 = a2 + kstep; const char* b3 = b2 + kstep;
            PG8_LDB(B0, 0, 0); PG8_LDB(B1, 0, 1); PG8_SCHED; PG8_LDA(At, 0, 0); PG8_STAGE(PG8_SA(1, 1), a1 + hstepA, voffA);
            PG8_WAIT_V(8); PG8_WAIT_L(0); PG8_BAR; PG8_MMA(0, 0, At, B0); PG8_MMA(0, 1, At, B1); PG8_BAR; PG8_SCHED;
            PG8_LDA(At, 0, 1); PG8_STAGE(PG8_SB(0, 0), b2, voffB); PG8_STAGE(PG8_SB(0, 1), b2 + hstepB, voffB); PG8_STAGE(PG8_SA(0, 0), a2, voffA);
            PG8_WAIT_V(8); PG8_WAIT_L(0); PG8_BAR; PG8_MMA(1, 0, At, B0); PG8_MMA(1, 1, At, B1); PG8_BAR; PG8_SCHED;
            PG8_LDB(B0, 1, 0); PG8_LDB(B1, 1, 1); PG8_SCHED; PG8_LDA(At, 1, 0); PG8_STAGE(PG8_SA(0, 1), a2 + hstepA, voffA);
            PG8_WAIT_V(8); PG8_WAIT_L(0); PG8_BAR; PG8_MMA(0, 0, At, B0); PG8_MMA(0, 1, At, B1); PG8_BAR; PG8_SCHED;
            PG8_LDA(At, 1, 1); PG8_STAGE(PG8_SB(1, 0), b3, voffB); PG8_STAGE(PG8_SB(1, 1), b3 + hstepB, voffB); PG8_STAGE(PG8_SA(1, 0), a3, voffA);
            PG8_WAIT_V(8); PG8_WAIT_L(0); PG8_BAR; PG8_MMA(1, 0, At, B0); PG8_MMA(1, 1, At, B1); PG8_BAR; PG8_SCHED;
        }
        if constexpr (ALIGN_EPI) { if (wr == 0) PG8_BAR; }
        if constexpr (F8) { asm volatile("s_nop 15\n\ts_nop 15" ::: "memory"); }
        E(acc, cur, wr, wc, fr, fq);
        if (!has_next) break;
#pragma unroll
        for (int a = 0; a < 2; ++a)
#pragma unroll
            for (int b = 0; b < 2; ++b)
#pragma unroll
                for (int m = 0; m < 4; ++m)
#pragma unroll
                    for (int n = 0; n < 2; ++n) acc[a][b][m][n] = (f32x4){0.f, 0.f, 0.f, 0.f};
        cur = nxt; cA = nA; cB = nB; ++ui;
        if constexpr (ALIGN_EPI) { if (wr == 1) PG8_BAR; }
    }
    PG8_WAIT_V(0);
    if constexpr (!ALIGN_EPI) { if (wr == 0) PG8_BAR; }
    PG8_BAR;
#undef PG8_SA
#undef PG8_SB
#undef PG8_STAGE
#undef PG8_LDA
#undef PG8_LDB
#undef PG8_MMA
#undef PG8_CAT
#undef PG8_WAIT_V
#undef PG8_WAIT_L
#undef PG8_BAR
#undef PG8_SCHED
}
}

struct Frame {
    LAS unsigned char* lds;
    int tid, lane, wave, G, gw, ngw;
    const float* in[20];
    float* out; unsigned char* ws;
};
enum { I_X = 0, I_META, I_LN0G, I_LN0B, I_RELB, I_WIN, I_WUK, I_WUV, I_WGK2, I_BGK, I_GNG, I_WOUT, I_LN1G, I_LN1B, I_WPQ, I_SUBK, I_UTAB, I_VTAB, I_LN2G, I_LN2B };

__device__ __forceinline__ void ln_stats(f32x4 (&v)[8], float& mean, float& rstd) {
    float s = 0.f;
#pragma unroll
    for (int j = 0; j < 8; ++j) s += (v[j].x + v[j].y) + (v[j].z + v[j].w);
    mean = wave_sum(s) * (1.f / DM); float s2 = 0.f;
#pragma unroll
    for (int j = 0; j < 8; ++j) { v[j] = v[j] - mean; s2 += (v[j].x * v[j].x + v[j].y * v[j].y) + (v[j].z * v[j].z + v[j].w * v[j].w); }
    rstd = 1.f / sqrtf(wave_sum(s2) * (1.f / DM) + LN_EPS);
}
__device__ __forceinline__ void ln_row_to_bf16(const float* xrow, const float* g, const float* b, bf16_t* orow, int lane, unsigned* f8row = nullptr, float* stats = nullptr) {
    const f32x4* xr = (const f32x4*)xrow + lane; f32x4 v[8];
#pragma unroll
    for (int j = 0; j < 8; ++j) v[j] = xr[64 * j];
    float mean, rstd; ln_stats(v, mean, rstd);
    if (stats && lane == 0) *(f32x2*)stats = (f32x2){mean, rstd};
    const f32x4* gr = (const f32x4*)g + lane; const f32x4* br = (const f32x4*)b + lane;
    u32x2* o8 = (u32x2*)orow + lane;
#pragma unroll
    for (int j = 0; j < 8; ++j) { const f32x4 gg = gr[64 * j], bb = br[64 * j]; const f32x4 y = v[j] * rstd * gg + bb;
        u32x2 w; w.x = cvtpk(y.x, y.y); w.y = cvtpk(y.z, y.w); o8[64 * j] = w;
        if (f8row) { int q = 0; q = __builtin_amdgcn_cvt_pk_fp8_f32(y.x, y.y, q, false); q = __builtin_amdgcn_cvt_pk_fp8_f32(y.z, y.w, q, true); f8row[lane + 64 * j] = (unsigned)q; } }
}
__device__ __forceinline__ void ln_row_to_f32(const float* xrow, const float* g, const float* b, float* orow, int lane) {
    const f32x4* xr = (const f32x4*)xrow + lane; f32x4 v[8];
#pragma unroll
    for (int j = 0; j < 8; ++j) v[j] = xr[64 * j];
    float mean, rstd; ln_stats(v, mean, rstd);
    const f32x4* gr = (const f32x4*)g + lane; const f32x4* br = (const f32x4*)b + lane;
    f32x4* o = (f32x4*)orow + lane;
#pragma unroll
    for (int j = 0; j < 8; ++j) { const f32x4 gg = gr[64 * j], bb = br[64 * j]; o[64 * j] = v[j] * rstd * gg + bb; }
}
__device__ __forceinline__ void transpose_item(const float* W, int N, bf16_t* WT, int ldt, int row_off, float scale, LAS float* scr, int item, int lane) {
    const int nblk = N / 32, kb = item / nblk, nb = item % nblk, k0 = 64 * kb, n0 = 32 * nb;
#pragma unroll 8
    for (int i = 0; i < 32; ++i) { const int kk = 2 * i + (lane >> 5); scr[kk * 33 + (lane & 31)] = W[(size_t)(k0 + kk) * N + n0 + (lane & 31)]; }
    LDS_WAIT(); asm volatile("" ::: "memory");
    const int c = lane & 7;
#pragma unroll
    for (int j = 0; j < 4; ++j) { const int n = (lane >> 3) + 8 * j; const LAS float* s = scr + (8 * c) * 33 + n;
        u32x4 o; o.x = cvtpk(s[0 * 33] * scale, s[1 * 33] * scale); o.y = cvtpk(s[2 * 33] * scale, s[3 * 33] * scale); o.z = cvtpk(s[4 * 33] * scale, s[5 * 33] * scale); o.w = cvtpk(s[6 * 33] * scale, s[7 * 33] * scale);
        *(u32x4*)(WT + (size_t)(row_off + n0 + n) * ldt + k0 + 8 * c) = o; }
    LDS_WAIT(); asm volatile("" ::: "memory");
}
__device__ __forceinline__ void transpose_item_f8(const float* W, int N, unsigned char* WT, size_t ldt, float scale, LAS float* scr, int item, int lane) {
    const int nblk = N / 32, kb = item / nblk, nb = item % nblk, k0 = 64 * kb, n0 = 32 * nb;
#pragma unroll 8
    for (int i = 0; i < 32; ++i) { const int kk = 2 * i + (lane >> 5); scr[kk * 33 + (lane & 31)] = W[(size_t)(k0 + kk) * N + n0 + (lane & 31)]; }
    LDS_WAIT(); asm volatile("" ::: "memory");
    const int c = lane & 7;
#pragma unroll
    for (int j = 0; j < 4; ++j) { const int n = (lane >> 3) + 8 * j; const LAS float* s = scr + (8 * c) * 33 + n;
        int w0 = 0, w1 = 0;
        w0 = __builtin_amdgcn_cvt_pk_fp8_f32(s[0 * 33] * scale, s[1 * 33] * scale, w0, false); w0 = __builtin_amdgcn_cvt_pk_fp8_f32(s[2 * 33] * scale, s[3 * 33] * scale, w0, true);
        w1 = __builtin_amdgcn_cvt_pk_fp8_f32(s[4 * 33] * scale, s[5 * 33] * scale, w1, false); w1 = __builtin_amdgcn_cvt_pk_fp8_f32(s[6 * 33] * scale, s[7 * 33] * scale, w1, true);
        *(u32x2*)(WT + (size_t)(n0 + n) * ldt + k0 + 8 * c) = (u32x2){(unsigned)w0, (unsigned)w1}; }
    LDS_WAIT(); asm volatile("" ::: "memory");
}
__device__ __forceinline__ void convert_f32_f8(const float* src, unsigned char* dst, float scale, size_t n8, size_t i0, size_t stride) {
    for (size_t i = i0; i < n8; i += stride) { const f32x4 a = ((const f32x4*)src)[2 * i] * scale, b = ((const f32x4*)src)[2 * i + 1] * scale;
        int w0 = 0, w1 = 0;
        w0 = __builtin_amdgcn_cvt_pk_fp8_f32(a.x, a.y, w0, false); w0 = __builtin_amdgcn_cvt_pk_fp8_f32(a.z, a.w, w0, true);
        w1 = __builtin_amdgcn_cvt_pk_fp8_f32(b.x, b.y, w1, false); w1 = __builtin_amdgcn_cvt_pk_fp8_f32(b.z, b.w, w1, true);
        ((u32x2*)dst)[i] = (u32x2){(unsigned)w0, (unsigned)w1}; }
}
__device__ __forceinline__ void convert_f32_bf16(const float* src, bf16_t* dst, size_t n8, size_t i0, size_t stride) {
    for (size_t i = i0; i < n8; i += stride) { const f32x4 a = ((const f32x4*)src)[2 * i], b = ((const f32x4*)src)[2 * i + 1];
        u32x4 w; w.x = cvtpk(a.x, a.y); w.y = cvtpk(a.z, a.w); w.z = cvtpk(b.x, b.y); w.w = cvtpk(b.z, b.w); ((u32x4*)dst)[i] = w; }
}
__device__ __forceinline__ int t5_bucket(int rel) {
    const int n = rel < 0 ? -rel : rel;
    const int f = n < 8 ? n : (n < 12 ? 8 : (n < 16 ? 9 : (n < 23 ? 10 : (n < 32 ? 11 : (n < 46 ? 12 : (n < 64 ? 13 : (n < 91 ? 14 : 15)))))));
    return (rel > 0 ? 16 : 0) + f;
}
constexpr float WPQ_S = 64.f;
constexpr int BT_OFF = 2080, BT_N = 2144;

__device__ __forceinline__ void p0_prologue(Frame& F) {
    LAS float* scr = (LAS float*)(F.lds + F.wave * 8704);
    bf16_t* H0 = (bf16_t*)(F.ws + WS_H0);
    for (int m = F.gw; m < T + NMETA; m += F.ngw) {
        const float* src = m < T ? F.in[I_X] + (size_t)m * DM : F.in[I_META] + (size_t)(m - T) * DM;
        ln_row_to_bf16(src, F.in[I_LN0G], F.in[I_LN0B], H0 + (size_t)m * DM, F.lane, nullptr, m < T ? (float*)(F.ws + WS_ST0) + 2 * (size_t)m : nullptr);
    }
    { u32x4* z = (u32x4*)(H0 + (size_t)(T + NMETA) * DM); const size_t n = (size_t)(TM - T - NMETA) * DM / 8;
      for (size_t i = (size_t)F.gw * 64 + F.lane; i < n; i += (size_t)F.ngw * 64) z[i] = (u32x4){0u, 0u, 0u, 0u}; }
    constexpr int I_IN = (DM / 64) * (INC / 32), I_O = (DM / 64) * (DM / 32), I_KV = 8 * (256 / 64) * (128 / 32);
    constexpr int NITEMS = I_IN + 2 * I_O + 2 * I_KV;
    for (int it = F.gw; it < NITEMS; it += F.ngw) {
        int r = it;
        if (r < I_IN) { transpose_item(F.in[I_WIN], INC, (bf16_t*)(F.ws + WS_WIN), DM, 0, 1.f, scr, r, F.lane); continue; } r -= I_IN;
        if (r < I_O) { transpose_item(F.in[I_WOUT], DM, (bf16_t*)(F.ws + WS_WO), DM, 0, 1.f, scr, r, F.lane); continue; } r -= I_O;
        if (r < I_O) { transpose_item(F.in[I_WPQ], DM, (bf16_t*)(F.ws + WS_WPQ), DM, 0, 1.f, scr, r, F.lane); continue; } r -= I_O;
        if (r < I_KV) { const int h = r / 16; transpose_item(F.in[I_WUK] + (size_t)h * 256 * 128, 128, (bf16_t*)(F.ws + WS_WKV), 256, h * 128, 0.08838834764831845f * LOG2E, scr, r % 16, F.lane); continue; } r -= I_KV;
        { const int h = r / 16; transpose_item(F.in[I_WUV] + (size_t)h * 256 * 128, 128, (bf16_t*)(F.ws + WS_WKV), 256, 1024 + h * 128, 1.f, scr, r % 16, F.lane); }
    }
    convert_f32_bf16(F.in[I_SUBK], (bf16_t*)(F.ws + WS_SKB), (size_t)16 * 128 * 128 / 8, (size_t)F.gw * 64 + F.lane, (size_t)F.ngw * 64);
    { float* bt = (float*)(F.ws + WS_BT);
      for (int i = F.gw * 64 + F.lane; i < 8 * BT_N; i += F.ngw * 64) { const int h = i / BT_N, rel = i % BT_N - BT_OFF; bt[i] = F.in[I_RELB][t5_bucket(rel) * 8 + h] * LOG2E; } }
}

__device__ __forceinline__ void kv_meta(Frame& F) {
    const bf16_t* PROJ = (const bf16_t*)(F.ws + WS_PROJ); const bf16_t* WKV = (const bf16_t*)(F.ws + WS_WKV); bf16_t* KVP = (bf16_t*)(F.ws + WS_KVP);
    const int l16 = F.lane & 15, q4 = F.lane >> 4;
    for (int j = F.gw; j < 128; j += F.ngw) {
        f32x4 acc = {0.f, 0.f, 0.f, 0.f};
#pragma unroll
        for (int s = 0; s < 8; ++s) acc = __builtin_amdgcn_mfma_f32_16x16x32_bf16(*(const bf16x8*)(PROJ + (size_t)(T + l16) * INP + C_CKV + 32 * s + 8 * q4), *(const bf16x8*)(WKV + (size_t)(16 * j + l16) * 256 + 32 * s + 8 * q4), acc, 0, 0, 0);
#pragma unroll
        for (int r = 0; r < 4; ++r) KVP[(size_t)(T + 4 * q4 + r) * 2048 + 16 * j + l16] = f2bf(acc[r]);
    }
    { u32x4* z = (u32x4*)(KVP + (size_t)(T + NMETA) * 2048); const int n = 48 * 2048 / 8;
      for (int i = F.gw * 64 + F.lane; i < n; i += F.ngw * 64) z[i] = (u32x4){0u, 0u, 0u, 0u}; }
}
constexpr int IDX_POOL_TILES = 33;
__device__ __forceinline__ void idx_dma(Frame& F, int b, int nrt, int first, int last) {
    const bf16_t* PROJ = (const bf16_t*)(F.ws + WS_PROJ);
    const int lane = F.lane;
    for (int t = first + F.wave; t < last; t += 8) {
#pragma unroll
        for (int i = 0; i < 4; ++i) { const int p = i * 64 + lane, key = p >> 3, ch = (p & 7) ^ ((key >> 1) & 7);
            const size_t krow = t < nrt ? (size_t)(b * SEQ + 32 * t + key) : (size_t)(T + key);
            __builtin_amdgcn_global_load_lds((const unsigned*)(PROJ + krow * INP + C_IK + 8 * ch), (LAS unsigned*)(F.lds + (t - first) * 4096 + i * 1024), 16, 0, 0); }
    }
}
__device__ __forceinline__ void idx_phase(Frame& F) {
    const bf16_t* PROJ = (const bf16_t*)(F.ws + WS_PROJ);
    unsigned* BM = (unsigned*)(F.ws + WS_BM);
    const int lane = F.lane, n = lane & 31, hi = lane >> 5, w = F.wave;
    const float NINF = -__builtin_inff();
    const int nunits = NB * 128;
    int u = blockIdx.x;
    if (u < nunits) { const int b = u >> 7, gr = u & 127, g = ((b >> 1) & 1) ? 127 - gr : gr, nrt = 2 * ((g >> 2) + 1); idx_dma(F, b, nrt, 0, min(nrt + 1, IDX_POOL_TILES)); }
    for (; u < nunits; u += F.G) {
        const int b = u >> 7, gr = u & 127, g = ((b >> 1) & 1) ? 127 - gr : gr, c = g >> 2, nrt = 2 * (c + 1), ntile = nrt + 1;
        const int q0 = 16 * g + 2 * w;
        bf16x8 af[4];
#pragma unroll
        for (int s2 = 0; s2 < 4; ++s2) af[s2] = *(const bf16x8*)(PROJ + (size_t)(b * SEQ + q0 + (n >> 4)) * INP + C_IQ + (n & 15) * 64 + 16 * s2 + 8 * hi);
        float iw0[8], iw1[8];
#pragma unroll
        for (int r = 0; r < 8; ++r) { const int h = (r & 3) + 8 * (r >> 2) + 4 * hi;
            iw0[r] = bf2f(PROJ[(size_t)(b * SEQ + q0) * INP + C_IW + h]); iw1[r] = bf2f(PROJ[(size_t)(b * SEQ + q0 + 1) * INP + C_IW + h]); }
        float v[66];
        const LAS unsigned char* rb = F.lds + n * 128;
        const int sw = (n >> 1) & 7;
#define IDX_TILE(t_, slot_) do { const int tt = (t_); \
            f32x16 acc = {}; \
            _Pragma("unroll") for (int s2 = 0; s2 < 4; ++s2) acc = __builtin_amdgcn_mfma_f32_32x32x16_bf16(af[s2], *(const LAS bf16x8*)(rb + (slot_) * 4096 + (((2 * s2 + hi) ^ sw) << 4)), acc, 0, 0, 0); \
            float p0 = 0.f, p1 = 0.f; \
            _Pragma("unroll") for (int r = 0; r < 8; ++r) { p0 += fmaxf(acc[r], 0.f) * iw0[r]; p1 += fmaxf(acc[8 + r], 0.f) * iw1[r]; } \
            const auto rr = __builtin_amdgcn_permlane32_swap(__float_as_uint(p0), __float_as_uint(p1), false, false); \
            float tot = __uint_as_float(rr[0]) + __uint_as_float(rr[1]); \
            if (tt > nrt || (tt == nrt && n >= NMETA)) tot = NINF; \
            v[t_] = tot; } while (0)
        asm volatile("s_waitcnt vmcnt(0)" ::: "memory"); __syncthreads();
#pragma unroll
        for (int t = 0; t < 34; t += 2) { v[t] = NINF; v[t + 1] = NINF; if (t < ntile && t < IDX_POOL_TILES) { IDX_TILE(t, t); if (t + 1 < IDX_POOL_TILES) IDX_TILE(t + 1, t + 1); } }
        __syncthreads();
        if (ntile > IDX_POOL_TILES) {
            idx_dma(F, b, nrt, IDX_POOL_TILES, ntile);
            asm volatile("s_waitcnt vmcnt(0)" ::: "memory"); __syncthreads();
#pragma unroll
            for (int t = 34; t < 66; t += 2) { v[t] = NINF; v[t + 1] = NINF; }
            IDX_TILE(33, 0);
#pragma unroll
            for (int t = 34; t < 66; t += 2) { if (t < ntile) { IDX_TILE(t, t - IDX_POOL_TILES); if (t + 1 < 65) IDX_TILE(t + 1, t + 1 - IDX_POOL_TILES); } }
            __syncthreads();
        } else {
#pragma unroll
            for (int t = 34; t < 66; ++t) v[t] = NINF;
        }
#undef IDX_TILE
        { const int u2 = u + F.G; if (u2 < nunits) { const int b2 = u2 >> 7, gr2 = u2 & 127, g2 = ((b2 >> 1) & 1) ? 127 - gr2 : gr2, nrt2 = 2 * ((g2 >> 2) + 1); idx_dma(F, b2, nrt2, 0, min(nrt2 + 1, IDX_POOL_TILES)); } }
        float thr = -3.0e38f;
        if (c >= 3) {
            float mn = __builtin_inff(), mx = NINF;
#pragma unroll
            for (int t = 0; t < 65; ++t) { mx = fmaxf(mx, v[t]); mn = fminf(mn, v[t] > NINF ? v[t] : mn); }
#pragma unroll
            for (int o = 1; o < 32; o <<= 1) { mn = fminf(mn, __shfl_xor(mn, o)); mx = fmaxf(mx, __shfl_xor(mx, o)); }
            float lo = mn, hh = mx; bool done = false; thr = mn;
            for (int it = 0; it < 64; ++it) {
                const float mid = 0.5f * lo + 0.5f * hh;
                if (!done && !(mid > lo && mid < hh)) { thr = lo; done = true; }
                if (__all(done)) break;
                int cnt = 0;
#pragma unroll
                for (int t = 0; t < 22; ++t) cnt += (v[t] >= mid) ? 1 : 0;
                if (nrt >= 22) {
#pragma unroll
                    for (int t = 22; t < 44; ++t) cnt += (v[t] >= mid) ? 1 : 0; }
                if (nrt >= 44) {
#pragma unroll
                    for (int t = 44; t < 65; ++t) cnt += (v[t] >= mid) ? 1 : 0; }
#pragma unroll
                for (int o = 1; o < 32; o <<= 1) cnt += __shfl_xor(cnt, o);
                if (!done) { if (cnt == 256) { thr = mid; done = true; } else if (cnt > 256) lo = mid; else hh = mid; }
            }
            if (!done) thr = lo;
        }
        unsigned w0 = 0u, w1 = 0u, w2 = 0u;
#pragma unroll
        for (int t = 0; t < 65; ++t) {
            const unsigned long long bal = __ballot(v[t] >= thr && v[t] > NINF);
            const unsigned mine = hi ? (unsigned)(bal >> 32) : (unsigned)bal;
            const bool ismeta = (t == nrt);
            if (t < 32) { if (!ismeta && n == t) w0 = mine; } else if (t < 64) { if (!ismeta && n == t - 32) w1 = mine; }
            if (ismeta && n == 0) w2 = mine;
        }
        unsigned* bm = BM + (size_t)(b * SEQ + q0 + hi) * 66;
        bm[n] = w0; bm[32 + n] = w1; if (n < 2) bm[64 + n] = w2;
    }
    asm volatile("s_waitcnt vmcnt(0)" ::: "memory"); __syncthreads();
}

namespace att {
constexpr int SHM_V = 64 * 128 * 2, SHM_K = 64 * 128 * 2;
constexpr int OFF_V = 0, OFF_K = 2 * SHM_V, OFF_WS = OFF_K + 2 * SHM_K, OFF_BT = OFF_WS + NWAVES * 256, BTW = 384, BT_ZERO = 320;
#define KSWZ(row, colB) ((row) * 256 + ((colB) ^ (((row) & 7) << 4)))
__device__ __forceinline__ int v_st(int k, int c) { const int kk = (k & ~0xC) | ((k & 4) << 1) | ((k & 8) >> 1); return ((kk >> 3) * 4 + (c >> 5)) * 512 + ((kk & 7) * 32 + (c & 31)) * 2; }
__device__ __forceinline__ int v_rd_base(int lane) { return ((lane & 3) << 3) | (((lane >> 2) & 3) << 6) | (((lane >> 4) & 1) << 5) | (((lane >> 5) & 1) << 8); }
constexpr int v_rd_off(int d0, int ks, int half) { return d0 * 512 + ks * 4096 + half * 2048; }
template <int OFF> __device__ __forceinline__ s16x4 tr_read(int vb) { s16x4 r; asm volatile("ds_read_b64_tr_b16 %0, %1 offset:%2" : "=&v"(r) : "v"(vb), "i"(OFF) : "memory"); return r; }
template <int D0> __device__ __forceinline__ void pv_one(f32x16& od, int vb, bf16x8 pa0, bf16x8 pa1, bf16x8 pa2, bf16x8 pa3) {
    const s16x4 l0 = tr_read<v_rd_off(D0, 0, 0)>(vb), h0 = tr_read<v_rd_off(D0, 0, 1)>(vb), l1 = tr_read<v_rd_off(D0, 1, 0)>(vb), h1 = tr_read<v_rd_off(D0, 1, 1)>(vb);
    const s16x4 l2 = tr_read<v_rd_off(D0, 2, 0)>(vb), h2 = tr_read<v_rd_off(D0, 2, 1)>(vb), l3 = tr_read<v_rd_off(D0, 3, 0)>(vb), h3 = tr_read<v_rd_off(D0, 3, 1)>(vb);
    asm volatile("s_waitcnt lgkmcnt(0)" ::: "memory"); SBAR();
#define PK(L, H) (bf16x8){L[0], L[1], L[2], L[3], H[0], H[1], H[2], H[3]}
    od = __builtin_amdgcn_mfma_f32_32x32x16_bf16(pa0, PK(l0, h0), od, 0, 0, 0);
    od = __builtin_amdgcn_mfma_f32_32x32x16_bf16(pa1, PK(l1, h1), od, 0, 0, 0);
    od = __builtin_amdgcn_mfma_f32_32x32x16_bf16(pa2, PK(l2, h2), od, 0, 0, 0);
    od = __builtin_amdgcn_mfma_f32_32x32x16_bf16(pa3, PK(l3, h3), od, 0, 0, 0);
#undef PK
}
__device__ __forceinline__ void qkt(f32x16& p0, f32x16& p1, const LAS unsigned char* Ks, const bf16x8* qr, int r32, int hi) {
    p0 = f32x16{}; p1 = f32x16{};
#pragma unroll
    for (int d0 = 0; d0 < 8; ++d0) { const int cb = (d0 * 16 + hi * 8) * 2;
        const bf16x8 b0 = *(const LAS bf16x8*)(Ks + KSWZ(r32, cb));
        const bf16x8 b1 = *(const LAS bf16x8*)(Ks + KSWZ(32 + r32, cb));
        p0 = __builtin_amdgcn_mfma_f32_32x32x16_bf16(b0, qr[d0], p0, 0, 0, 0);
        p1 = __builtin_amdgcn_mfma_f32_32x32x16_bf16(b1, qr[d0], p1, 0, 0, 0); }
}
template <bool NEAR>
__device__ __forceinline__ void tile_sm(f32x16& p0, f32x16& p1, float& m_reg, float& l_reg, float& alpha, bf16x8& pa0, bf16x8& pa1, bf16x8& pa2, bf16x8& pa3,
                                        float cb, const LAS float* btl, unsigned mlo, unsigned mhi, int hi) {
    if (NEAR) {
#pragma unroll
        for (int r = 0; r < 16; ++r) { p0[r] += btl[(r & 3) + 8 * (r >> 2)]; p1[r] += btl[32 + (r & 3) + 8 * (r >> 2)]; }
    }
    float pmax = p0[0];
#pragma unroll
    for (int r = 1; r < 16; ++r) pmax = fmaxf(pmax, p0[r]);
#pragma unroll
    for (int r = 0; r < 16; ++r) pmax = fmaxf(pmax, p1[r]);
    { const auto rr = __builtin_amdgcn_permlane32_swap(__float_as_uint(pmax), __float_as_uint(pmax), false, false); pmax = fmaxf(__uint_as_float(rr[0]), __uint_as_float(rr[1])); }
    if (!NEAR) pmax += cb;
    const float mn = fmaxf(m_reg, pmax); alpha = __builtin_amdgcn_exp2f(m_reg - mn); m_reg = mn;
    const float off = (NEAR ? 0.f : cb) - mn;
    const unsigned w0 = mlo >> (4 * hi), w1 = mhi >> (4 * hi);
    float ps = 0.f;
#pragma unroll
    for (int r = 0; r < 16; ++r) { const int pos = (r & 3) + 8 * (r >> 2);
        const float e0 = __builtin_amdgcn_exp2f(p0[r] + off), e1 = __builtin_amdgcn_exp2f(p1[r] + off);
        p0[r] = __uint_as_float(__float_as_uint(e0) & (unsigned)__builtin_amdgcn_sbfe((int)w0, pos, 1));
        p1[r] = __uint_as_float(__float_as_uint(e1) & (unsigned)__builtin_amdgcn_sbfe((int)w1, pos, 1));
        ps += p0[r] + p1[r]; }
    { const auto rr = __builtin_amdgcn_permlane32_swap(__float_as_uint(ps), __float_as_uint(ps), false, false); ps = __uint_as_float(rr[0]) + __uint_as_float(rr[1]); }
    l_reg = l_reg * alpha + ps;
#define PK4(P, BASE, OUT) do { unsigned a0 = cvtpk(P[BASE + 0], P[BASE + 1]), a1 = cvtpk(P[BASE + 2], P[BASE + 3]);   \
    unsigned b0 = cvtpk(P[BASE + 4], P[BASE + 5]), b1 = cvtpk(P[BASE + 6], P[BASE + 7]);                              \
    auto r0 = __builtin_amdgcn_permlane32_swap(a0, b0, false, false); auto r1 = __builtin_amdgcn_permlane32_swap(a1, b1, false, false); \
    u32x4 w = {r0[0], r1[0], r0[1], r1[1]}; OUT = *reinterpret_cast<bf16x8*>(&w); } while (0)
    PK4(p0, 0, pa0); PK4(p0, 8, pa1); PK4(p1, 0, pa2); PK4(p1, 8, pa3);
#undef PK4
}
__device__ __forceinline__ void attn_unit(Frame& F, int b, int h, int qb) {
    const bf16_t* PROJ = (const bf16_t*)(F.ws + WS_PROJ); const bf16_t* KVP = (const bf16_t*)(F.ws + WS_KVP);
    const unsigned long long* BM = (const unsigned long long*)(F.ws + WS_BM);
    const float* BT = (const float*)(F.ws + WS_BT);
    bf16_t* YM = (bf16_t*)(F.ws + WS_YMIX);
    LAS unsigned char* lds = F.lds;
    const int tid = F.tid, wid = F.wave, lane = F.lane, r32 = lane & 31, hi = lane >> 5;
    LAS unsigned char* V_lds = lds + OFF_V; LAS unsigned char* K_lds = lds + OFF_K;
    LAS float* wsl = (LAS float*)(lds + OFF_WS) + wid * 64; LAS float* li_l = wsl; LAS float* al_l = wsl + 32;
    LAS float* btw = (LAS float*)(lds + OFF_BT) + wid * BTW;
    for (int i = lane; i < BTW; i += 64) btw[i] = BT[h * BT_N + (i - BT_ZERO + BT_OFF)];
    const int q0w = 256 * qb + 32 * wid, q = q0w + r32;
    const size_t tq = (size_t)(b * SEQ + q);
    const int nreal = 4 * (qb + 1), NT = nreal + 1;
    float m_reg = -1e30f, l_reg = 0.f; f32x16 o[4] = {}; bf16x8 qr[8];
    { const bf16_t* Qw = PROJ + tq * INP + C_AQ + h * 128 + hi * 8;
#pragma unroll
      for (int d0 = 0; d0 < 8; ++d0) qr[d0] = *(const bf16x8*)(Qw + d0 * 16); }
    const int sr = tid >> 4, sc = (tid & 15) * 8, vst0 = v_st(sr, sc), vst1 = v_st(32 + sr, sc);
    const int vb0 = (int)(unsigned)(size_t)V_lds + v_rd_base(lane);
    bf16x8 vs0, vs1, ks0, ks1;
    const bf16_t* Kh = KVP + h * 128 + sc; const bf16_t* Vh = KVP + 1024 + h * 128 + sc;
#define A_SLOAD(j) do { const size_t kb_ = (j) < nreal ? (size_t)(b * SEQ + 64 * (j)) : (size_t)T; \
    vs0 = *(const bf16x8*)(Vh + (kb_ + sr) * 2048); vs1 = *(const bf16x8*)(Vh + (kb_ + 32 + sr) * 2048); \
    ks0 = *(const bf16x8*)(Kh + (kb_ + sr) * 2048); ks1 = *(const bf16x8*)(Kh + (kb_ + 32 + sr) * 2048); } while (0)
#define A_SWRITE(bf) do { *(LAS bf16x8*)(V_lds + (bf) * SHM_V + vst0) = vs0; *(LAS bf16x8*)(V_lds + (bf) * SHM_V + vst1) = vs1; \
    *(LAS bf16x8*)(K_lds + (bf) * SHM_K + KSWZ(sr, sc * 2)) = ks0; *(LAS bf16x8*)(K_lds + (bf) * SHM_K + KSWZ(32 + sr, sc * 2)) = ks1; } while (0)
#define A_RESC(a) do { if (__any((a) < 1.f)) { if (hi == 0) al_l[r32] = (a); asm volatile("s_waitcnt lgkmcnt(0)" ::: "memory"); \
    _Pragma("unroll") for (int d = 0; d < 4; ++d) _Pragma("unroll") for (int r = 0; r < 16; ++r) o[d][r] *= al_l[crow(r, hi)]; } } while (0)
    const float cbfar = BT[h * BT_N + (-200 + BT_OFF)];
    A_SLOAD(0); unsigned long long mk = BM[tq * 33 + 0];
    VM_WAIT(); A_SWRITE(0); __syncthreads();
    for (int j = 0; j < NT; ++j) {
        const int cur = j & 1; const bool more = (j + 1 < NT);
        unsigned long long mkn = 0ull;
        if (more) { A_SLOAD(j + 1); mkn = BM[tq * 33 + ((j + 1) < nreal ? (j + 1) : 32)]; }
        f32x16 p0, p1; float alpha; bf16x8 pa0, pa1, pa2, pa3;
        qkt(p0, p1, K_lds + cur * SHM_K, qr, r32, hi);
        const bool meta = (j >= nreal);
        const bool nearT = meta ? (q0w < 96) : (64 * j + 63 - q0w > -91);
        if (nearT) { const int base = (meta ? (-16 - q) : (64 * j - q)) + BT_ZERO + 4 * hi;
            tile_sm<true>(p0, p1, m_reg, l_reg, alpha, pa0, pa1, pa2, pa3, 0.f, btw + base, (unsigned)mk, (unsigned)(mk >> 32), hi); }
        else tile_sm<false>(p0, p1, m_reg, l_reg, alpha, pa0, pa1, pa2, pa3, cbfar, btw, (unsigned)mk, (unsigned)(mk >> 32), hi);
        A_RESC(alpha);
        const int vb = vb0 + cur * SHM_V;
        pv_one<0>(o[0], vb, pa0, pa1, pa2, pa3); pv_one<1>(o[1], vb, pa0, pa1, pa2, pa3); pv_one<2>(o[2], vb, pa0, pa1, pa2, pa3); pv_one<3>(o[3], vb, pa0, pa1, pa2, pa3);
        if (more) { VM_WAIT(); A_SWRITE(cur ^ 1); }
        mk = mkn;
        __syncthreads();
    }
    if (hi == 0) li_l[r32] = l_reg; asm volatile("s_waitcnt lgkmcnt(0)" ::: "memory");
    float rli[16];
#pragma unroll
    for (int r = 0; r < 16; ++r) rli[r] = __builtin_amdgcn_rcpf(li_l[crow(r, hi)]);
    bf16_t* Ow = YM + (size_t)(b * SEQ + q0w) * DM + h * 128;
#pragma unroll
    for (int r = 0; r < 16; ++r) { const int orow = crow(r, hi);
#pragma unroll
        for (int d0 = 0; d0 < 4; ++d0) Ow[(size_t)orow * DM + d0 * 32 + r32] = f2bf(o[d0][r] * rli[r]); }
    __syncthreads();
#undef A_SLOAD
#undef A_SWRITE
#undef A_RESC
}
__device__ __forceinline__ void attn_phase(Frame& F) {
    for (int u = blockIdx.x; u < 512; u += F.G) { const int bh = (u >> 2) & 63, p = u & 3, qb = (u >= 256) ? 7 - p : p;
        attn_unit(F, bh >> 3, bh & 7, qb); }
}
#undef KSWZ
}

__device__ __forceinline__ size_t gla_row(int b, int c, int i) { return c == 0 ? (size_t)(T + i - 48) : (size_t)(b * SEQ + (c - 1) * 64 + i); }
__device__ __forceinline__ void gla_prep_unit(Frame& F, int b, int h, int c) {
    const bf16_t* PROJ = (const bf16_t*)(F.ws + WS_PROJ);
    bf16_t* QT = (bf16_t*)(F.ws + WS_QT); bf16_t* KTT = (bf16_t*)(F.ws + WS_KTT); bf16_t* VT = (bf16_t*)(F.ws + WS_VT); bf16_t* AT = (bf16_t*)(F.ws + WS_AT);
    float* EB = (float*)(F.ws + WS_EB);
    LAS unsigned char* lds = F.lds;
    LAS bf16_t* Qs = (LAS bf16_t*)lds;
    LAS bf16_t* Ks = (LAS bf16_t*)(lds + 64 * 136 * 2);
    LAS float* tot = (LAS float*)(lds + 2 * 64 * 136 * 2);
    LAS float* grs = tot + 512;
    const int tid = F.tid, d = tid & 127, ig = tid >> 7, G = b * NCH + c;
    u32x4 gl = {0u, 0u, 0u, 0u};
    if (tid < 128) { const int i = tid >> 1; if (c > 0 || i >= 48) gl = *(const u32x4*)(PROJ + gla_row(b, c, i) * INP + C_GR + 8 * (tid & 1)); }
    unsigned qk[16];
#pragma unroll
    for (int ii = 0; ii < 16; ++ii) { const int i = 16 * ig + ii; qk[ii] = 0u;
        if (c > 0 || i >= 48) { const size_t row = gla_row(b, c, i); qk[ii] = (unsigned)PROJ[row * INP + C_GQ + h * 128 + d] | ((unsigned)PROJ[row * INP + C_GK + h * 128 + d] << 16); } }
    unsigned vpk[16];
    { const int v = tid & 255, ih = tid >> 8;
#pragma unroll
      for (int j = 0; j < 16; ++j) { const int i0 = 32 * ih + 2 * j; unsigned lo = 0u, hi2 = 0u;
          if (c > 0 || i0 >= 48) lo = PROJ[gla_row(b, c, i0) * INP + C_GV + h * 256 + v];
          if (c > 0 || i0 + 1 >= 48) hi2 = PROJ[gla_row(b, c, i0 + 1) * INP + C_GV + h * 256 + v];
          vpk[j] = lo | (hi2 << 16); } }
    float wv[16];
#pragma unroll
    for (int r = 0; r < 16; ++r) wv[r] = F.in[I_WGK2][r * 512 + h * 128 + d];
    const float bg = F.in[I_BGK][h * 128 + d];
    if (tid < 128) { LAS float* gp = grs + (tid >> 1) * 16 + 8 * (tid & 1);
        gp[0] = bflo(gl.x); gp[1] = bfhi(gl.x); gp[2] = bflo(gl.y); gp[3] = bfhi(gl.y); gp[4] = bflo(gl.z); gp[5] = bfhi(gl.z); gp[6] = bflo(gl.w); gp[7] = bfhi(gl.w); }
    __syncthreads();
    float bl[16]; float run = 0.f;
#pragma unroll
    for (int ii = 0; ii < 16; ++ii) { const int i = 16 * ig + ii; const bool valid = (c > 0) || (i >= 48);
        const f32x4 a0 = *(const LAS f32x4*)(grs + i * 16), a1 = *(const LAS f32x4*)(grs + i * 16 + 4), a2 = *(const LAS f32x4*)(grs + i * 16 + 8), a3 = *(const LAS f32x4*)(grs + i * 16 + 12);
        float x = bg + a0.x * wv[0] + a0.y * wv[1] + a0.z * wv[2] + a0.w * wv[3] + a1.x * wv[4] + a1.y * wv[5] + a1.z * wv[6] + a1.w * wv[7]
                     + a2.x * wv[8] + a2.y * wv[9] + a2.z * wv[10] + a2.w * wv[11] + a3.x * wv[12] + a3.y * wv[13] + a3.z * wv[14] + a3.w * wv[15];
        const float gk = valid ? (fminf(x, 0.f) - __logf(1.f + __expf(-fabsf(x)))) * (1.f / 16.f) : 0.f;
        run += gk; bl[ii] = run; }
    tot[ig * 128 + d] = run;
    __syncthreads();
    float offs = 0.f, blast = 0.f;
#pragma unroll
    for (int gI = 0; gI < 4; ++gI) { const float tv = tot[gI * 128 + d]; blast += tv; if (gI < ig) offs += tv; }
#pragma unroll
    for (int ii = 0; ii < 16; ++ii) { const int i = 16 * ig + ii;
        const float bc = bl[ii] + offs;
        const bf16_t qt = f2bf(bflo(qk[ii]) * __expf(bc) * 0.08838834764831845f), kt = f2bf(bfhi(qk[ii]) * __expf(-bc));
        QT[((size_t)G * 64 + i) * 512 + h * 128 + d] = qt;
        Qs[i * 136 + d] = qt; Ks[i * 136 + d] = kt; }
    if (ig == 0) EB[(size_t)G * 512 + h * 128 + d] = __expf(blast);
    { const int v = tid & 255, ih = tid >> 8; u32x4* dst = (u32x4*)(VT + ((size_t)G * 1024 + h * 256 + v) * 64 + 32 * ih);
#pragma unroll
      for (int j = 0; j < 4; ++j) dst[j] = (u32x4){vpk[4 * j], vpk[4 * j + 1], vpk[4 * j + 2], vpk[4 * j + 3]}; }
    __syncthreads();
    { const int jg = ig; unsigned pk[8];
#pragma unroll
      for (int j = 0; j < 8; ++j) pk[j] = (unsigned)Ks[(16 * jg + 2 * j) * 136 + d] | ((unsigned)Ks[(16 * jg + 2 * j + 1) * 136 + d] << 16);
      u32x4* dst = (u32x4*)(KTT + (((size_t)G * 4 + h) * 128 + d) * 64 + 16 * jg);
      dst[0] = (u32x4){pk[0], pk[1], pk[2], pk[3]}; dst[1] = (u32x4){pk[4], pk[5], pk[6], pk[7]}; }
    if (F.wave < 4) { const int w = F.wave, ib = (w == 0 || w == 3) ? 0 : 1, jb = (w == 2 || w == 3) ? 1 : 0; const int n = F.lane & 31, hi = F.lane >> 5;
        f32x16 acc = {};
        if (w < 3) {
#pragma unroll
            for (int s = 0; s < 8; ++s) { const bf16x8 a = *(const LAS bf16x8*)(Qs + (32 * ib + n) * 136 + 16 * s + 8 * hi), bb = *(const LAS bf16x8*)(Ks + (32 * jb + n) * 136 + 16 * s + 8 * hi);
                acc = __builtin_amdgcn_mfma_f32_32x32x16_bf16(a, bb, acc, 0, 0, 0); } }
        bf16_t* dst = AT + (((size_t)G * 4 + h) * 64) * 64;
#pragma unroll
        for (int r = 0; r < 16; ++r) { const int i = 32 * ib + crow(r, hi), j = 32 * jb + n; dst[i * 64 + j] = f2bf(j <= i ? acc[r] : 0.f); } }
    __syncthreads();
}
__device__ __forceinline__ void gla_prep_phase(Frame& F) {
    for (int u = blockIdx.x; u < NB * NCH * 4; u += F.G) { const int h = u & 3, bc = u >> 2; gla_prep_unit(F, bc / NCH, h, bc % NCH); }
}
struct GlaOps { bf16x8 ka0, ka1, v00, v01, v10, v11; f32x4 eb; };
__device__ __forceinline__ void gla_load_ops(GlaOps& o, const bf16_t* KTT, const bf16_t* VT, const float* EB, int G, int h, int vs, int w, int l16, int q4) {
    const bf16_t* kt = KTT + (((size_t)G * 4 + h) * 128 + 16 * w + l16) * 64 + 8 * q4;
    const bf16_t* vt = VT + ((size_t)G * 1024 + h * 256 + 32 * vs + l16) * 64 + 8 * q4;
    o.ka0 = *(const bf16x8*)(kt); o.ka1 = *(const bf16x8*)(kt + 32);
    o.v00 = *(const bf16x8*)(vt); o.v01 = *(const bf16x8*)(vt + 32); o.v10 = *(const bf16x8*)(vt + 16 * 64); o.v11 = *(const bf16x8*)(vt + 16 * 64 + 32);
    o.eb = *(const f32x4*)(EB + (size_t)G * 512 + h * 128 + 16 * w + 4 * q4);
}
__device__ __forceinline__ void gla_scan_task(Frame& F, int b, int h, int vs, int w) {
    const bf16_t* KTT = (const bf16_t*)(F.ws + WS_KTT); const bf16_t* VT = (const bf16_t*)(F.ws + WS_VT); const float* EB = (const float*)(F.ws + WS_EB);
    bf16_t* SST = (bf16_t*)(F.ws + WS_SST);
    const int lane = F.lane, l16 = lane & 15, q4 = lane >> 4, G0 = b * NCH;
    f32x4 S0 = {0.f, 0.f, 0.f, 0.f}, S1 = {0.f, 0.f, 0.f, 0.f};
    for (int c0 = 0; c0 < NCH - 1; c0 += 6) {
        GlaOps o[6];
#pragma unroll
        for (int k = 0; k < 6; ++k) if (c0 + k < NCH - 1) gla_load_ops(o[k], KTT, VT, EB, G0 + c0 + k, h, vs, w, l16, q4);
        u32x2 r0[6], r1[6];
#pragma unroll
        for (int k = 0; k < 6; ++k) if (c0 + k < NCH - 1) {
            S0 = __builtin_amdgcn_mfma_f32_16x16x32_bf16(o[k].ka0, o[k].v00, S0, 0, 0, 0); S0 = __builtin_amdgcn_mfma_f32_16x16x32_bf16(o[k].ka1, o[k].v01, S0, 0, 0, 0);
            S1 = __builtin_amdgcn_mfma_f32_16x16x32_bf16(o[k].ka0, o[k].v10, S1, 0, 0, 0); S1 = __builtin_amdgcn_mfma_f32_16x16x32_bf16(o[k].ka1, o[k].v11, S1, 0, 0, 0);
            S0 = S0 * o[k].eb; S1 = S1 * o[k].eb;
            r0[k] = (u32x2){cvtpk(S0[0], S0[1]), cvtpk(S0[2], S0[3])}; r1[k] = (u32x2){cvtpk(S1[0], S1[1]), cvtpk(S1[2], S1[3])}; }
#pragma unroll
        for (int k = 0; k < 6; ++k) if (c0 + k < NCH - 1) {
            bf16_t* so = SST + (((size_t)(G0 + c0 + k) * 4 + h) * 256 + 32 * vs + l16) * 128 + 16 * w + 4 * q4;
            *(u32x2*)(so) = r0[k]; *(u32x2*)(so + 16 * 128) = r1[k]; }
    }
}
__device__ __forceinline__ void gla_scan_phase(Frame& F) {
    for (int u = F.gw; u < NB * 4 * 8 * 8; u += F.ngw) gla_scan_task(F, u >> 8, (u >> 6) & 3, (u >> 3) & 7, u & 7);
}
__device__ __forceinline__ void gla_out_unit(Frame& F, int b, int h, int c) {
    const bf16_t* PROJ = (const bf16_t*)(F.ws + WS_PROJ); const bf16_t* QT = (const bf16_t*)(F.ws + WS_QT); const bf16_t* AT = (const bf16_t*)(F.ws + WS_AT);
    const bf16_t* VT = (const bf16_t*)(F.ws + WS_VT); const bf16_t* SST = (const bf16_t*)(F.ws + WS_SST);
    bf16_t* YM = (bf16_t*)(F.ws + WS_YMIX);
    LAS float* part = (LAS float*)F.lds;
    const int w = F.wave, lane = F.lane, l16 = lane & 15, q4 = lane >> 4, G = b * NCH + c;
    bf16x8 sb[2][4], vb[2][2];
#pragma unroll
    for (int vh = 0; vh < 2; ++vh) { const bf16_t* sp = SST + (((size_t)(G - 1) * 4 + h) * 256 + 32 * w + 16 * vh + l16) * 128 + 8 * q4;
        const bf16_t* vp = VT + ((size_t)G * 1024 + h * 256 + 32 * w + 16 * vh + l16) * 64 + 8 * q4;
#pragma unroll
        for (int s2 = 0; s2 < 4; ++s2) sb[vh][s2] = *(const bf16x8*)(sp + 32 * s2);
        vb[vh][0] = *(const bf16x8*)(vp); vb[vh][1] = *(const bf16x8*)(vp + 32); }
    unsigned short xg[4][4][2];
#pragma unroll
    for (int it = 0; it < 4; ++it)
#pragma unroll
        for (int r = 0; r < 4; ++r) { const size_t trow = (size_t)(b * SEQ + (c - 1) * 64 + 16 * it + 4 * q4 + r);
            xg[it][r][0] = PROJ[trow * INP + C_GO + h * 256 + 32 * w + l16]; xg[it][r][1] = PROJ[trow * INP + C_GO + h * 256 + 32 * w + 16 + l16]; }
    f32x4 oa[4][2];
#pragma unroll
    for (int it = 0; it < 4; ++it) { const bf16_t* qp = QT + ((size_t)G * 64 + 16 * it + l16) * 512 + h * 128 + 8 * q4; const bf16_t* ap = AT + (((size_t)G * 4 + h) * 64 + 16 * it + l16) * 64 + 8 * q4;
        const bf16x8 q0 = *(const bf16x8*)(qp), q1 = *(const bf16x8*)(qp + 32), q2 = *(const bf16x8*)(qp + 64), q3 = *(const bf16x8*)(qp + 96), a0 = *(const bf16x8*)(ap), a1 = *(const bf16x8*)(ap + 32);
#pragma unroll
        for (int vh = 0; vh < 2; ++vh) { f32x4 a = {0.f, 0.f, 0.f, 0.f};
            a = __builtin_amdgcn_mfma_f32_16x16x32_bf16(q0, sb[vh][0], a, 0, 0, 0); a = __builtin_amdgcn_mfma_f32_16x16x32_bf16(q1, sb[vh][1], a, 0, 0, 0);
            a = __builtin_amdgcn_mfma_f32_16x16x32_bf16(q2, sb[vh][2], a, 0, 0, 0); a = __builtin_amdgcn_mfma_f32_16x16x32_bf16(q3, sb[vh][3], a, 0, 0, 0);
            a = __builtin_amdgcn_mfma_f32_16x16x32_bf16(a0, vb[vh][0], a, 0, 0, 0); a = __builtin_amdgcn_mfma_f32_16x16x32_bf16(a1, vb[vh][1], a, 0, 0, 0);
            oa[it][vh] = a; } }
#pragma unroll
    for (int it = 0; it < 4; ++it)
#pragma unroll
        for (int r = 0; r < 4; ++r) { float ss = oa[it][0][r] * oa[it][0][r] + oa[it][1][r] * oa[it][1][r];
            ss += __shfl_xor(ss, 1); ss += __shfl_xor(ss, 2); ss += __shfl_xor(ss, 4); ss += __shfl_xor(ss, 8);
            if (l16 == 0) part[(16 * it + 4 * q4 + r) * 8 + w] = ss; }
    __syncthreads();
    const float g0 = F.in[I_GNG][32 * w + l16], g1 = F.in[I_GNG][32 * w + 16 + l16];
#pragma unroll
    for (int it = 0; it < 4; ++it)
#pragma unroll
        for (int r = 0; r < 4; ++r) { const int i = 16 * it + 4 * q4 + r;
            const f32x4 p0 = *(const LAS f32x4*)(part + i * 8), p1 = *(const LAS f32x4*)(part + i * 8 + 4);
            const float rstd = 1.f / sqrtf(((p0.x + p0.y) + (p0.z + p0.w) + (p1.x + p1.y) + (p1.z + p1.w)) * (1.f / 256.f) + LN_EPS);
            const size_t trow = (size_t)(b * SEQ + (c - 1) * 64 + i);
            const float x0 = bf2f(xg[it][r][0]), x1 = bf2f(xg[it][r][1]);
            const float y0 = oa[it][0][r] * rstd * g0 * (x0 / (1.f + __expf(-x0))), y1 = oa[it][1][r] * rstd * g1 * (x1 / (1.f + __expf(-x1)));
            YM[trow * DM + 1024 + h * 256 + 32 * w + l16] = f2bf(y0); YM[trow * DM + 1024 + h * 256 + 32 * w + 16 + l16] = f2bf(y1); }
    __syncthreads();
}
__device__ __forceinline__ void gla_out_phase(Frame& F) {
    for (int u = blockIdx.x; u < NB * 4 * 32; u += F.G) gla_out_unit(F, u >> 7, (u >> 5) & 3, 1 + (u & 31));
}

__device__ __forceinline__ int f2key(float f) { const int b = __float_as_int(f); return b ^ ((b >> 31) & 0x7fffffff); }
__device__ __forceinline__ float key2f(int k) { return __int_as_float(k ^ ((k >> 31) & 0x7fffffff)); }
#define CEX(a, b) do { const int _t = max(a, b); b = min(a, b); a = _t; } while (0)
__device__ __forceinline__ void sort16_desc(int (&x)[16]) {
#pragma unroll
    for (int k = 2; k <= 16; k <<= 1)
#pragma unroll
        for (int j = k >> 1; j > 0; j >>= 1)
#pragma unroll
            for (int i = 0; i < 16; ++i) { const int l = i ^ j; if (l > i) { if ((i & k) == 0) CEX(x[i], x[l]); else CEX(x[l], x[i]); } }
}
__device__ __forceinline__ void merge16_desc(int (&a)[16], const int (&b)[16]) {
#pragma unroll
    for (int i = 0; i < 16; ++i) a[i] = max(a[i], b[15 - i]);
#pragma unroll
    for (int j = 8; j > 0; j >>= 1)
#pragma unroll
        for (int i = 0; i < 16; ++i) { const int l = i ^ j; if (l > i) CEX(a[i], a[l]); }
}
__device__ __forceinline__ void peer_topk_task(Frame& F, int t0, int h) {
    const bf16_t* QH = (const bf16_t*)(F.ws + WS_QH); const bf16_t* SKB = (const bf16_t*)(F.ws + WS_SKB);
    unsigned short* EIDX = (unsigned short*)(F.ws + WS_EIDX); float* GATE = (float*)(F.ws + WS_GATE);
    const int lane = F.lane, r32 = lane & 31, hi = lane >> 5;
    int L1[16], L2[16];
#pragma unroll
    for (int c = 0; c < 2; ++c) {
        f32x16 acc[4] = {};
        const bf16_t* qp = QH + (size_t)(t0 + r32) * DM + (h * 2 + c) * 128 + 8 * hi;
        const bf16_t* kp = SKB + ((size_t)(h * 2 + c) * 128 + r32) * 128 + 8 * hi;
#pragma unroll
        for (int s = 0; s < 8; ++s) { const bf16x8 bq = *(const bf16x8*)(qp + 16 * s);
#pragma unroll
            for (int nt = 0; nt < 4; ++nt) acc[nt] = __builtin_amdgcn_mfma_f32_32x32x16_bf16(*(const bf16x8*)(kp + (size_t)nt * 32 * 128 + 16 * s), bq, acc[nt], 0, 0, 0); }
        int L[16], M[16];
#pragma unroll
        for (int nt = 0; nt < 4; ++nt) {
#pragma unroll
            for (int r = 0; r < 16; ++r) { const int n = 32 * nt + (r & 3) + 8 * (r >> 2) + 4 * hi; M[r] = (f2key(acc[nt][r]) & ~127) | n; }
            sort16_desc(M);
            if (nt == 0) {
#pragma unroll
                for (int i = 0; i < 16; ++i) L[i] = M[i];
            } else merge16_desc(L, M);
        }
#pragma unroll
        for (int i = 0; i < 16; ++i) M[i] = __shfl_xor(L[i], 32);
        merge16_desc(L, M);
#pragma unroll
        for (int i = 0; i < 16; ++i) { if (c == 0) L1[i] = L[i]; else L2[i] = L[i]; }
    }
    int Lc[16], M[16]; int nm = 0;
#pragma unroll
    for (int j = 0; j < 16; ++j) { const float sm = key2f(L1[0] & ~127) + key2f(L2[j] & ~127); Lc[j] = (f2key(sm) & ~16383) | ((L1[0] & 127) << 7) | (L2[j] & 127); }
#pragma unroll
    for (int i = 1; i < 16; ++i)
#pragma unroll
        for (int j = 0; j < 16; ++j) if ((i + 1) * (j + 1) <= 16) { const float sm = key2f(L1[i] & ~127) + key2f(L2[j] & ~127);
            M[nm & 15] = (f2key(sm) & ~16383) | ((L1[i] & 127) << 7) | (L2[j] & 127); ++nm;
            if ((nm & 15) == 0) { sort16_desc(M); merge16_desc(Lc, M); } }
    { M[2] = M[3] = M[4] = M[5] = M[6] = M[7] = M[8] = M[9] = M[10] = M[11] = M[12] = M[13] = M[14] = M[15] = (int)0x80000000;
      if (M[0] < M[1]) { const int t_ = M[0]; M[0] = M[1]; M[1] = t_; }
      merge16_desc(Lc, M); }
    float ev[16]; float esum = 0.f; const float vmax = key2f(Lc[0] & ~16383);
#pragma unroll
    for (int k = 0; k < 16; ++k) { ev[k] = __expf(key2f(Lc[k] & ~16383) - vmax); esum += ev[k]; }
    const float rs = 1.f / esum;
    const size_t t = (size_t)(t0 + r32);
#pragma unroll
    for (int k = 0; k < 16; ++k) if ((k >> 3) == hi) { EIDX[t * 128 + h * 16 + k] = (unsigned short)(Lc[k] & 16383); GATE[t * 128 + h * 16 + k] = ev[k] * rs; }
}
__device__ __forceinline__ void peer_topk_phase(Frame& F) {
    for (int u = F.gw; u < (T / 32) * 8; u += F.ngw) peer_topk_task(F, (u >> 3) * 32, u & 7);
}

__device__ __forceinline__ void peer_mask_phase(Frame& F) {
    const unsigned short* EIDX = (const unsigned short*)(F.ws + WS_EIDX); const float* GATE = (const float*)(F.ws + WS_GATE);
    unsigned char* C8 = F.ws + WS_C; const int lane = F.lane;
    for (int r0 = 4 * F.gw; r0 < T; r0 += 4 * F.ngw) {
        int e0[4], e1[4]; float g0[4], g1[4], t0[4], t1[4]; unsigned a0[4], a1[4];
#pragma unroll
        for (int i = 0; i < 4; ++i) { const size_t t = (size_t)(r0 + i); e0[i] = EIDX[t * 128 + lane]; e1[i] = EIDX[t * 128 + 64 + lane]; g0[i] = GATE[t * 128 + lane]; g1[i] = GATE[t * 128 + 64 + lane]; }
#pragma unroll
        for (int i = 0; i < 4; ++i) { const unsigned char* crow = C8 + (size_t)(r0 + i) * NEXP; a0[i] = crow[e0[i]]; a1[i] = crow[e1[i]]; }
#pragma unroll
        for (int i = 0; i < 4; ++i) { float s0 = 0.f, s1 = 0.f;
            for (int k = 0; k < 64; ++k) { const int ek = __builtin_amdgcn_readlane(e0[i], k); const float gk = __uint_as_float(__builtin_amdgcn_readlane(__float_as_uint(g0[i]), k));
                s0 += (e0[i] == ek) ? gk : 0.f; s1 += (e1[i] == ek) ? gk : 0.f; }
            for (int k = 0; k < 64; ++k) { const int ek = __builtin_amdgcn_readlane(e1[i], k); const float gk = __uint_as_float(__builtin_amdgcn_readlane(__float_as_uint(g1[i]), k));
                s0 += (e0[i] == ek) ? gk : 0.f; s1 += (e1[i] == ek) ? gk : 0.f; }
            t0[i] = s0; t1[i] = s1; }
        asm volatile("s_waitcnt vmcnt(0)" ::: "memory");
        unsigned char o0[4], o1[4];
#pragma unroll
        for (int i = 0; i < 4; ++i) {
            const float x0 = __builtin_amdgcn_cvt_f32_fp8((int)a0[i], 0) * (1.f / pg8::PEER_SA), x1 = __builtin_amdgcn_cvt_f32_fp8((int)a1[i], 0) * (1.f / pg8::PEER_SA);
            o0[i] = (unsigned char)(__builtin_amdgcn_cvt_pk_fp8_f32(t0[i] * pg8::PEER_SC * pg8::gelu_exact(x0), 0.f, 0, false) & 255);
            o1[i] = (unsigned char)(__builtin_amdgcn_cvt_pk_fp8_f32(t1[i] * pg8::PEER_SC * pg8::gelu_exact(x1), 0.f, 0, false) & 255); }
#pragma unroll
        for (int i = 0; i < 4; ++i) { u32x4* z = (u32x4*)(C8 + (size_t)(r0 + i) * NEXP);
#pragma unroll
            for (int j = 0; j < 16; ++j) z[j * 64 + lane] = (u32x4){0u, 0u, 0u, 0u}; }
        asm volatile("s_waitcnt vmcnt(0)" ::: "memory");
#pragma unroll
        for (int i = 0; i < 4; ++i) { unsigned char* crow = C8 + (size_t)(r0 + i) * NEXP; crow[e0[i]] = o0[i]; crow[e1[i]] = o1[i]; }
    }
}

struct Args { const float* in[20]; float* out; unsigned char* ws; int ph_lo, ph_hi; };
constexpr int N_PHASES = 16;
__global__ void __launch_bounds__(NTHREADS, 2) mk_fwd(Args args) {
    extern __shared__ __attribute__((aligned(16))) unsigned char lds_raw[];
    Frame F;
    F.lds = (LAS unsigned char*)lds_raw;
    F.tid = threadIdx.x; F.lane = F.tid & 63; F.wave = __builtin_amdgcn_readfirstlane(F.tid >> 6);
    F.G = gridDim.x; F.gw = blockIdx.x * NWAVES + F.wave; F.ngw = F.G * NWAVES;
#pragma unroll
    for (int i = 0; i < 20; ++i) F.in[i] = args.in[i];
    F.out = args.out; F.ws = args.ws;
    volatile LAS unsigned* lctl = (volatile LAS unsigned*)(F.lds + LDSCTL_OFF);
    if (F.tid < 64) lctl[F.tid] = 0u;
    __syncthreads();
    unsigned* ctl = (unsigned*)(F.ws + WS_CTL);
    const int lo = args.ph_lo, hi = args.ph_hi;
    XcdBarrier bar; bar.bar = ctl + 1024; bar.x = 0; bar.st = lctl + 8;
    if (hi - lo > 1) bar = xcd_barrier_post(ctl + 1024, lctl + 8);
#define IN(k) (lo <= (k) && (k) < hi)
#define SEAM(k) do { if (IN(k) && IN((k) + 1)) xcd_barrier(bar); } while (0)
#define LOCAL(k) do { if (IN(k) && IN((k) + 1)) __syncthreads(); } while (0)
    const int bid = blockIdx.x;
#define REFRESH() do { int t_ = threadIdx.x; asm volatile("" : "+v"(t_)); F.tid = t_; F.lane = t_ & 63; } while (0)

    if (IN(0)) { REFRESH(); p0_prologue(F); } SEAM(0);
    if (IN(1)) { REFRESH();
        pg8::Gemm g{(const bf16_t*)(F.ws + WS_H0), (const bf16_t*)(F.ws + WS_WIN), TM, INP, DM, DM, DM}; pg8::StaticOrder S; S.init(TM, INP, F.G, bid);
        pg8::EpiBf16 E{(bf16_t*)(F.ws + WS_PROJ), INP, 1.f};
        pg8::gemm_phase<pg8::EpiBf16, true>(F.lds, g, S, E);
    } SEAM(1);
    if (IN(2)) { REFRESH();
        kv_meta(F);
        pg8::Gemm g{(const bf16_t*)(F.ws + WS_PROJ) + C_CKV, (const bf16_t*)(F.ws + WS_WKV), T, 2048, 256, INP, 256}; pg8::StaticOrder S; S.init(T, 2048, F.G, bid);
        pg8::EpiBf16 E{(bf16_t*)(F.ws + WS_KVP), 2048, 1.f};
        pg8::gemm_phase<pg8::EpiBf16, true>(F.lds, g, S, E);
    } LOCAL(2);
    if (IN(3)) { REFRESH(); idx_phase(F); } LOCAL(3);
    if (IN(4)) { REFRESH(); gla_prep_phase(F); } SEAM(4);
    if (IN(5)) { REFRESH(); gla_scan_phase(F); } LOCAL(5);
    if (IN(6)) { REFRESH(); att::attn_phase(F); } SEAM(6);
    if (IN(7)) { REFRESH(); gla_out_phase(F); } SEAM(7);
    if (IN(8)) { REFRESH();
        pg8::Gemm g{(const bf16_t*)(F.ws + WS_YMIX), (const bf16_t*)(F.ws + WS_WO), T, DM, DM, DM, DM}; pg8::StaticOrder S; S.init(T, DM, F.G, bid);
        pg8::EpiResLn0 E{F.out, DM, F.in[I_X], (const float*)(F.ws + WS_ST0), F.in[I_LN0G], F.in[I_LN0B], ALPHA};
        pg8::gemm_phase<pg8::EpiResLn0, true>(F.lds, g, S, E);
    } SEAM(8);
    if (IN(9)) { REFRESH();
        bf16_t* H1 = (bf16_t*)(F.ws + WS_H1); unsigned* H1F8 = (unsigned*)(F.ws + WS_H1F8);
        for (int m = F.gw; m < T; m += F.ngw) ln_row_to_bf16(F.out + (size_t)m * DM, F.in[I_LN1G], F.in[I_LN1B], H1 + (size_t)m * DM, F.lane, H1F8 + (size_t)m * (DM / 4));
        convert_f32_f8(F.in[I_UTAB], F.ws + WS_UF8, pg8::PEER_SU, (size_t)NEXP * DM / 8, (size_t)F.gw * 64 + F.lane, (size_t)F.ngw * 64);
        { LAS float* scr = (LAS float*)(F.lds + F.wave * 8704);
          for (int it = F.gw; it < (NEXP / 64) * (DM / 32); it += F.ngw) transpose_item_f8(F.in[I_VTAB], DM, F.ws + WS_VF8, NEXP, pg8::PEER_SV, scr, it, F.lane); }
    } SEAM(9);
    if (IN(10)) { REFRESH();
        pg8::Gemm g{(const bf16_t*)(F.ws + WS_H1), (const bf16_t*)(F.ws + WS_WPQ), T, DM, DM, DM, DM}; pg8::StaticOrder S; S.init(T, DM, F.G, bid);
        pg8::EpiBf16 E{(bf16_t*)(F.ws + WS_QH), DM, 1.f};
        pg8::gemm_phase<pg8::EpiBf16, true>(F.lds, g, S, E);
    } SEAM(10);
    if (IN(11)) { REFRESH(); peer_topk_phase(F); } LOCAL(11);
    if (IN(12)) { REFRESH();
        pg8::Gemm g{(const bf16_t*)(F.ws + WS_H1F8), (const bf16_t*)(F.ws + WS_UF8), T, NEXP, DM / 2, DM / 2, DM / 2}; pg8::StaticOrder S; S.init(T, NEXP, F.G, bid);
        pg8::EpiF8 E{F.ws + WS_C, NEXP, pg8::PEER_SA / pg8::PEER_SU};
        pg8::gemm_phase<pg8::EpiF8, true, true>(F.lds, g, S, E);
    } SEAM(12);
    if (IN(13)) { REFRESH(); peer_mask_phase(F); } SEAM(13);
    if (IN(14)) { REFRESH();
        pg8::Gemm g{(const bf16_t*)(F.ws + WS_C), (const bf16_t*)(F.ws + WS_VF8), T, DM, NEXP / 2, NEXP / 2, NEXP / 2}; pg8::StaticOrder S; S.init(T, DM, F.G, bid);
        pg8::EpiResF32 E{F.out, DM, (const bf16_t*)(F.ws + WS_H1), DM, ALPHA, 1.f / (pg8::PEER_SC * pg8::PEER_SV)};
        pg8::gemm_phase<pg8::EpiResF32, true, true>(F.lds, g, S, E);
    } SEAM(14);
    if (IN(15)) { REFRESH(); for (int m = F.gw; m < T; m += F.ngw) ln_row_to_f32(F.out + (size_t)m * DM, F.in[I_LN2G], F.in[I_LN2B], F.out + (size_t)m * DM, F.lane); }
#undef LOCAL
#undef REFRESH
#undef IN
#undef SEAM
}

#ifndef MK_TAILSEQ
#define MK_TAILSEQ {-1}
#endif
#ifndef MK_REPS
#define MK_REPS {1,1,1,1,1,1,1,1,1,1,1,1,1,1,1,1}
#endif
#ifndef MK_ONE_LAUNCH
#define MK_ONE_LAUNCH 1
#endif
extern "C" void kernel_launch(void* const* d_in, const int* in_sizes, int n_in, void* d_out, int out_size, void* d_ws, size_t ws_size, hipStream_t stream) {
    static int grid = 0;
    if (grid == 0) {
        if (n_in != 20 || out_size != T * DM || ws_size < WS_END) { fprintf(stderr, "kernel_launch: shape mismatch n_in %d out %d ws %zu (need %zu)\n", n_in, out_size, ws_size, (size_t)WS_END); grid = -1; return; }
        int dev = 0, cus = 0, per_cu = 0;
        if (hipGetDevice(&dev) != hipSuccess || hipDeviceGetAttribute(&cus, hipDeviceAttributeMultiprocessorCount, dev) != hipSuccess) { grid = -1; return; }
        if (hipFuncSetAttribute((const void*)mk_fwd, hipFuncAttributeMaxDynamicSharedMemorySize, LDS_BYTES) != hipSuccess) { fprintf(stderr, "kernel_launch: hipFuncSetAttribute failed\n"); grid = -1; return; }
        if (hipOccupancyMaxActiveBlocksPerMultiprocessor(&per_cu, (const void*)mk_fwd, NTHREADS, LDS_BYTES) != hipSuccess || per_cu < 1) fprintf(stderr, "kernel_launch: occupancy query says %d\n", per_cu);
        (void)hipGetLastError();
        grid = cus;
    }
    if (grid < 0) return;
    (void)hipMemsetAsync((char*)d_ws + WS_CTL, 0, CTL_ZERO_BYTES, stream);
    Args a{};
    for (int i = 0; i < 20; ++i) a.in[i] = (const float*)d_in[i];
    a.out = (float*)d_out; a.ws = (unsigned char*)d_ws;
#if MK_ONE_LAUNCH
    a.ph_lo = 0; a.ph_hi = N_PHASES;
    hipLaunchKernelGGL(mk_fwd, dim3(grid), dim3(NTHREADS), LDS_BYTES, stream, a);
#else
    static const int reps[N_PHASES] = MK_REPS; static const int tailseq[] = MK_TAILSEQ;
    for (int p = 0; p < N_PHASES; ++p) for (int r = 0; r < reps[p]; ++r) { a.ph_lo = p; a.ph_hi = p + 1; hipLaunchKernelGGL(mk_fwd, dim3(grid), dim3(NTHREADS), LDS_BYTES, stream, a); }
    for (unsigned i = 0; i < sizeof(tailseq) / sizeof(int); ++i) if (tailseq[i] >= 0) { a.ph_lo = tailseq[i]; a.ph_hi = tailseq[i] + 1; hipLaunchKernelGGL(mk_fwd, dim3(grid), dim3(NTHREADS), LDS_BYTES, stream, a); }
#endif
}
```

```cpp
#include <hip/hip_runtime.h>
#include <cstdio>
#include <cstdint>

#define LAS __attribute__((address_space(3)))
#define GAS __attribute__((address_space(1)))
typedef unsigned short bf16_t;
typedef short bf16x8 __attribute__((ext_vector_type(8)));
typedef short s16x4 __attribute__((ext_vector_type(4)));
typedef float f32x2 __attribute__((ext_vector_type(2)));
typedef float f32x4 __attribute__((ext_vector_type(4)));
typedef float f32x16 __attribute__((ext_vector_type(16)));
typedef unsigned u32x2 __attribute__((ext_vector_type(2)));
typedef unsigned u32x4 __attribute__((ext_vector_type(4)));

constexpr int DM = 2048, NB = 8, SEQ = 2048, NMETA = 16, T = NB * SEQ, TM = T + 256;
constexpr int INC = 5472, INP = 5632;
constexpr int C_AQ = 0, C_CKV = 1024, C_IQ = 1280, C_IK = 2304, C_IW = 2368, C_GQ = 2384, C_GK = 2896, C_GV = 3408, C_GR = 4432, C_GO = 4448;
constexpr int NEXP = 16384;
constexpr float LN_EPS = 1e-5f, ALPHA = 1.189207115002721f, LOG2E = 1.4426950408889634f;
constexpr int NCH = 33;
constexpr int PCH = 8192;

constexpr size_t MiB = 1u << 20;
constexpr size_t WS_CTL = 0, CTL_ZERO_BYTES = 64 * 1024;
constexpr size_t WS_BT = 64 * 1024;
constexpr size_t WS_SKB = 256 * 1024;
constexpr size_t WS_WKV = 1 * MiB;
constexpr size_t WS_EB = 2 * MiB;
constexpr size_t WS_GSS = 3 * MiB;
constexpr size_t WS_H0 = 8 * MiB;
constexpr size_t WS_WIN = 73 * MiB;
constexpr size_t WS_SST = 8 * MiB;
constexpr size_t WS_QT = 74 * MiB;
constexpr size_t WS_AT = 90 * MiB + 512 * 1024;
constexpr size_t WS_ST0 = 7 * MiB;
constexpr size_t WS_PROJ = 99 * MiB;
constexpr size_t WS_KVP = 278 * MiB;
constexpr size_t WS_BM = 343 * MiB;
constexpr size_t WS_KTT = 348 * MiB;
constexpr size_t WS_VT = 365 * MiB;
constexpr size_t WS_GLAO = 398 * MiB;
constexpr size_t WS_YMIX = 430 * MiB;
constexpr size_t WS_WPQ = 496 * MiB;
constexpr size_t WS_WO = 504 * MiB;
constexpr size_t WS_H1 = 8 * MiB;
constexpr size_t WS_UF8 = 72 * MiB;
constexpr size_t WS_VF8 = 104 * MiB;
constexpr size_t WS_H1F8 = 136 * MiB;
constexpr size_t WS_EIDX = 168 * MiB;
constexpr size_t WS_GATE = 172 * MiB;
constexpr size_t WS_PBM = 212 * MiB;
constexpr size_t WS_C = 244 * MiB;
constexpr size_t WS_QH = 180 * MiB;
constexpr size_t WS_END = 512 * MiB;
static_assert(WS_C + (size_t)T * NEXP <= WS_WO, "C vs WoT");

constexpr int RING_BYTES = 135168;
constexpr int LDSCTL_OFF = 139264;
constexpr int LDS_BYTES = 147456;
constexpr int NWAVES = 8, NTHREADS = 512;

#define LDS_WAIT() asm volatile("s_waitcnt lgkmcnt(0)" ::: "memory")
#define VM_WAIT() asm volatile("s_waitcnt vmcnt(0)" ::: "memory")
#define SBAR() __builtin_amdgcn_sched_barrier(0)

typedef __bf16 bf16x2_t __attribute__((ext_vector_type(2)));
__device__ __forceinline__ unsigned cvtpk(float lo, float hi) { const f32x2 v = {lo, hi}; return __builtin_bit_cast(unsigned, __builtin_convertvector(v, bf16x2_t)); }
__device__ __forceinline__ bf16_t f2bf(float f) { return (bf16_t)(cvtpk(f, 0.f) & 0xffffu); }
__device__ __forceinline__ float bf2f(unsigned short b) { return __uint_as_float(((unsigned)b) << 16); }
__device__ __forceinline__ float bflo(unsigned w) { return __uint_as_float(w << 16); }
__device__ __forceinline__ float bfhi(unsigned w) { return __uint_as_float(w & 0xffff0000u); }
__device__ __forceinline__ float wave_sum(float v) {
#pragma unroll
    for (int o = 1; o < 64; o <<= 1) v += __shfl_xor(v, o);
    return v;
}
__device__ __forceinline__ int crow(int r, int hi) { return (r & 3) + 8 * (r >> 2) + 4 * hi; }

#define XB_TMO      128
#define XB_XCNT(j)  (256  + 64 * (j))
#define XB_XSUB(j)  (1280 + 64 * (j))
#define XB_XGEN(j)  (2304 + 64 * (j))
#define XB_TOP      3328
#define XB_TOPGEN   3392
#define XCD_BAR_WORDS 3456
#define XB_SPIN_CAP (1u << 18)
__device__ __forceinline__ unsigned xb_ld(unsigned* p)              { return __hip_atomic_load(p, __ATOMIC_RELAXED, __HIP_MEMORY_SCOPE_AGENT); }
__device__ __forceinline__ unsigned xb_add(unsigned* p, unsigned v) { return __hip_atomic_fetch_add(p, v, __ATOMIC_RELAXED, __HIP_MEMORY_SCOPE_AGENT); }
__device__ __forceinline__ unsigned xb_xcc_id() { return (unsigned)__builtin_amdgcn_s_getreg((3 << 11) | 20) & 0xFu; }
#define XB_SPIN(cond, bar) do { unsigned _sp = 0; while (cond) { __builtin_amdgcn_s_sleep(1); \
    if ((++_sp & 255u) == 0u) { if (xb_ld(&(bar)[XB_TMO])) break; if (_sp > XB_SPIN_CAP) { atomicAdd(&(bar)[XB_TMO], 1u); break; } } } } while (0)
struct XcdBarrier { unsigned* bar; unsigned x; volatile LAS unsigned* st; };
__device__ __forceinline__ XcdBarrier xcd_barrier_post(unsigned* bar, volatile LAS unsigned* st) {
    XcdBarrier b; b.bar = bar; b.x = xb_xcc_id(); b.st = st;
    if (threadIdx.x == 0) (void)xb_add(&bar[XB_XCNT(b.x)], 1u);
    return b;
}
__device__ __forceinline__ void xcd_barrier_complete(unsigned* bar, unsigned x, unsigned& nloc, unsigned& nx) {
    const unsigned G = gridDim.x * gridDim.y * gridDim.z;
    unsigned sum, cnt, mine, sp = 0u;
    for (;;) {
        sum = 0u; cnt = 0u; mine = 0u;
#pragma unroll
        for (unsigned j = 0; j < 16; ++j) { const unsigned c = xb_ld(&bar[XB_XCNT(j)]); sum += c; cnt += (c > 0u) ? 1u : 0u; mine = (j == x) ? c : mine; }
        if (sum == G) break;
        __builtin_amdgcn_s_sleep(1);
        if ((++sp & 255u) == 0u) { if (xb_ld(&bar[XB_TMO])) break; if (sp > XB_SPIN_CAP) { atomicAdd(&bar[XB_TMO], 1u); break; } }
    }
    nloc = mine > 0u ? mine : 1u; nx = cnt > 0u ? cnt : 1u;
}
__device__ __forceinline__ void xcd_barrier(const XcdBarrier& b) {
    asm volatile("s_waitcnt vmcnt(0)" ::: "memory");
    __syncthreads();
    if (threadIdx.x == 0) {
        unsigned* bar = b.bar;
        __builtin_amdgcn_s_waitcnt(0);
        unsigned nloc = b.st[0], nx = b.st[1];
        if (nloc == 0u) { xcd_barrier_complete(bar, b.x, nloc, nx); b.st[0] = nloc; b.st[1] = nx; }
        const unsigned old = xb_add(&bar[XB_XSUB(b.x)], 1u);
        const unsigned gen = old / nloc;
        if (old + 1u == (gen + 1u) * nloc) {
            __builtin_amdgcn_fence(__ATOMIC_RELEASE, "agent");
            asm volatile("s_waitcnt vmcnt(0)" ::: "memory");
            const unsigned og = xb_add(&bar[XB_TOP], 1u);
            const unsigned tg = og / nx;
            if (og + 1u == (tg + 1u) * nx) xb_add(&bar[XB_TOPGEN], 1u);
            else XB_SPIN(xb_ld(&bar[XB_TOPGEN]) == tg, bar);
            __builtin_amdgcn_fence(__ATOMIC_ACQUIRE, "agent");
            xb_add(&bar[XB_XGEN(b.x)], 1u);
            asm volatile("s_waitcnt vmcnt(0)" ::: "memory");
        } else {
            XB_SPIN(xb_ld(&bar[XB_XGEN(b.x)]) == gen, bar);
            __builtin_amdgcn_fence(__ATOMIC_ACQUIRE, "agent");
            asm volatile("s_waitcnt vmcnt(0)" ::: "memory");
        }
    }
    __syncthreads();
}

namespace pg8 {
constexpr int BM = 256, BK = 64, HALF = 128, HTB = HALF * BK * 2, STAGE_BYTES = 8 * HTB, NXCD = 8, WGM = 8;
__host__ __device__ __forceinline__ int lds_byte(int r, int c) { const int st = (r >> 4) * 2 + (c >> 5), rr = r & 15, cc = c & 31, ob = rr * 64 + cc * 2; return st * 1024 + (ob ^ (((ob >> 9) & 1) << 5)); }
__host__ __device__ __forceinline__ void stage_rc(int b, int& R, int& C) { const int st = b / 1024, sb = b % 1024, swz = sb ^ (((sb >> 9) & 1) << 5); R = (st >> 1) * 16 + swz / 64; C = (st & 1) * 32 + (swz % 64) / 2; }
__host__ __device__ __forceinline__ int perm32(int rho) { const int n = rho >> 4, i = rho & 15; return 8 * (i >> 2) + 4 * n + (i & 3); }
struct Unit { int pm, pn; };
struct Gemm { const bf16_t* A; const bf16_t* Bt; int M, N, K, lda, ldb; };
struct StaticOrder {
    int nM, nN, nwg, G, c;
    __host__ __device__ void init(int M, int N, int G_, int c_) { nM = M / BM; nN = N / BM; nwg = nM * nN; G = G_; c = c_; }
    __host__ __device__ bool next(int i, Unit& u) const {
        const long L = (long)i * G + c; if (L >= nwg) return false;
        int wgid = (int)L; { const int q = nwg / NXCD, r = nwg % NXCD, xcd = wgid % NXCD, off = wgid / NXCD; wgid = (xcd < r ? xcd * (q + 1) : r * (q + 1) + (xcd - r) * q) + off; }
        const int nig = WGM * nN, gid = wgid / nig, fm = gid * WGM, gsz = (nM - fm) < WGM ? (nM - fm) : WGM;
        u.pm = fm + ((wgid % nig) % gsz); u.pn = (wgid % nig) / gsz; return true;
    }
};
struct EpiBf16 {
    static constexpr bool PERM = true;
    bf16_t* O; int ldc; float sc;
    __device__ __forceinline__ void operator()(const f32x4 (&acc)[2][2][4][2], const Unit& u, int wr, int wc, int fr, int fq) const {
        const int row0 = u.pm * BM + wr * 64 + fr, col0 = u.pn * BM + wc * 32 + 8 * fq;
#pragma unroll
        for (int ai = 0; ai < 2; ++ai)
#pragma unroll
            for (int m = 0; m < 4; ++m) { bf16_t* rowp = O + (size_t)(row0 + ai * HALF + m * 16) * ldc + col0;
#pragma unroll
                for (int bj = 0; bj < 2; ++bj) { const f32x4 v0 = acc[ai][bj][m][0] * sc, v1 = acc[ai][bj][m][1] * sc;
                    u32x4 w; w.x = cvtpk(v0[0], v0[1]); w.y = cvtpk(v0[2], v0[3]); w.z = cvtpk(v1[0], v1[1]); w.w = cvtpk(v1[2], v1[3]);
                    *(u32x4*)(rowp + bj * HALF) = w; } }
    }
};
struct EpiResF32 {
    static constexpr bool PERM = false;
    float* out; int ldc; const bf16_t* base; int ldbase; float alpha; float sc;
    __device__ __forceinline__ void operator()(const f32x4 (&acc)[2][2][4][2], const Unit& u, int wr, int wc, int fr, int fq) const {
        const int row0 = u.pm * BM + wr * 64 + fr, col0 = u.pn * BM + wc * 32 + 4 * fq;
#pragma unroll
        for (int ai = 0; ai < 2; ++ai)
#pragma unroll
            for (int m = 0; m < 4; ++m) { const size_t row = (size_t)(row0 + ai * HALF + m * 16);
#pragma unroll
                for (int bj = 0; bj < 2; ++bj)
#pragma unroll
                    for (int n = 0; n < 2; ++n) { const int c = col0 + bj * HALF + n * 16;
                        const u32x2 bw = *(const u32x2*)(base + row * ldbase + c);
                        f32x4 o = acc[ai][bj][m][n] * sc;
                        o[0] += alpha * bflo(bw.x); o[1] += alpha * bfhi(bw.x); o[2] += alpha * bflo(bw.y); o[3] += alpha * bfhi(bw.y);
                        *(f32x4*)(out + row * ldc + c) = o; } }
    }
};
struct EpiResLn0 {
    static constexpr bool PERM = false;
    float* out; int ldc; const float* x; const float* st; const float* g; const float* b; float alpha;
    __device__ __forceinline__ void operator()(const f32x4 (&acc)[2][2][4][2], const Unit& u, int wr, int wc, int fr, int fq) const {
        const int row0 = u.pm * BM + wr * 64 + fr, col0 = u.pn * BM + wc * 32 + 4 * fq;
        f32x4 gg[2][2], bb[2][2];
#pragma unroll
        for (int bj = 0; bj < 2; ++bj)
#pragma unroll
            for (int n = 0; n < 2; ++n) { gg[bj][n] = *(const f32x4*)(g + col0 + bj * HALF + n * 16) * alpha; bb[bj][n] = *(const f32x4*)(b + col0 + bj * HALF + n * 16) * alpha; }
#pragma unroll
        for (int ai = 0; ai < 2; ++ai)
#pragma unroll
            for (int m = 0; m < 4; ++m) { const size_t row = (size_t)(row0 + ai * HALF + m * 16); const f32x2 ms = *(const f32x2*)(st + 2 * row);
#pragma unroll
                for (int bj = 0; bj < 2; ++bj)
#pragma unroll
                    for (int n = 0; n < 2; ++n) { const int c = col0 + bj * HALF + n * 16;
                        const f32x4 xv = *(const f32x4*)(x + row * ldc + c);
                        *(f32x4*)(out + row * ldc + c) = acc[ai][bj][m][n] + ((xv - ms.x) * ms.y) * gg[bj][n] + bb[bj][n]; } }
    }
};
__device__ __forceinline__ float gelu_exact(float v) {
    const float av = fabsf(v), t = __builtin_amdgcn_rcpf(av * 0.2316418882f + 1.0f);
    float q = t * 0.5307027145f + (-0.7265760135f); q = q * t + 0.7107068705f; q = q * t + (-0.142248368f); q = q * t + 0.127414796f; q = q * t;
    const float e = __builtin_amdgcn_exp2f((v * v) * (-0.72134752044f));
    const float m = v * (q * e);
    return v < 0.f ? m : v - m;
}
constexpr float PEER_SU = 64.f, PEER_SV = 8.f, PEER_SC = 64.f, PEER_SA = 32.f;
struct EpiF8 {
    static constexpr bool PERM = true;
    unsigned char* O; int ldc; float sc;
    __device__ __forceinline__ void operator()(const f32x4 (&acc)[2][2][4][2], const Unit& u, int wr, int wc, int fr, int fq) const {
        const int row0 = u.pm * BM + wr * 64 + fr, col0 = u.pn * BM + wc * 32 + 8 * fq;
#pragma unroll
        for (int ai = 0; ai < 2; ++ai)
#pragma unroll
            for (int m = 0; m < 4; ++m) { unsigned char* rowp = O + (size_t)(row0 + ai * HALF + m * 16) * ldc + col0;
#pragma unroll
                for (int bj = 0; bj < 2; ++bj) { const f32x4 v0 = acc[ai][bj][m][0] * sc, v1 = acc[ai][bj][m][1] * sc;
                    int w0 = 0, w1 = 0;
                    w0 = __builtin_amdgcn_cvt_pk_fp8_f32(v0[0], v0[1], w0, false); w0 = __builtin_amdgcn_cvt_pk_fp8_f32(v0[2], v0[3], w0, true);
                    w1 = __builtin_amdgcn_cvt_pk_fp8_f32(v1[0], v1[1], w1, false); w1 = __builtin_amdgcn_cvt_pk_fp8_f32(v1[2], v1[3], w1, true);
                    *(u32x2*)(rowp + bj * HALF) = (u32x2){(unsigned)w0, (unsigned)w1}; } }
    }
};

typedef int v8i_t __attribute__((ext_vector_type(8)));
typedef int v4i_t __attribute__((ext_vector_type(4)));
template <class Epi, bool ALIGN_EPI, bool F8 = false>
__device__ __forceinline__ void gemm_phase(LAS unsigned char* lds, const Gemm g, const StaticOrder& S, const Epi& E) {
    const int tid = threadIdx.x, wid = __builtin_amdgcn_readfirstlane(tid >> 6), lane = tid & 63, wr = wid >> 2, wc = wid & 3, fr = lane & 15, fq = lane >> 4;
    const int K = g.K, nt = K / BK;
    unsigned voffA[2], voffB[2];
#pragma unroll
    for (int i = 0; i < 2; ++i) { int R, C; stage_rc(tid * 16 + i * 8192, R, C); const int Rb = Epi::PERM ? ((R & ~31) + perm32(R & 31)) : R;
        voffA[i] = (unsigned)(R * g.lda + C) * 2u; voffB[i] = (unsigned)(Rb * g.ldb + C) * 2u; }
    const size_t kstep = (size_t)(BK * 2);
    const size_t hstepA = (size_t)HALF * g.lda * 2, hstepB = (size_t)HALF * g.ldb * 2;
    const size_t tstepA = 2 * hstepA, tstepB = 2 * hstepB;
    const unsigned ldsw = (unsigned)wid * 1024u;
    const int aoff = lds_byte(wr * 64 + fr, fq * 8), boff = lds_byte(wc * 32 + fr, fq * 8);
#define PG8_SA(b, h) (((b) * 2 + (h)) * HTB)
#define PG8_SB(b, h) ((4 + (b) * 2 + (h)) * HTB)
#define PG8_STAGE(bufoff, gbase, voff) do { _Pragma("unroll") for (int _i = 0; _i < 2; ++_i) \
        __builtin_amdgcn_global_load_lds((const unsigned*)((const char*)(gbase) + (voff)[_i]), (LAS unsigned*)(lds + (bufoff) + ldsw + _i * 8192), 16, 0, 0); } while (0)
#define PG8_LDA(dst, b, h) do { _Pragma("unroll") for (int m = 0; m < 4; ++m) _Pragma("unroll") for (int k = 0; k < 2; ++k) dst[m][k] = *(const LAS bf16x8*)(lds + PG8_SA(b, h) + aoff + m * 2048 + k * 1024); } while (0)
#define PG8_LDB(dst, b, h) do { _Pragma("unroll") for (int n = 0; n < 2; ++n) _Pragma("unroll") for (int k = 0; k < 2; ++k) dst[n][k] = *(const LAS bf16x8*)(lds + PG8_SB(b, h) + boff + n * 2048 + k * 1024); } while (0)
#define PG8_CAT(x) __builtin_shufflevector(__builtin_bit_cast(v4i_t, x[0]), __builtin_bit_cast(v4i_t, x[1]), 0, 1, 2, 3, 4, 5, 6, 7)
#define PG8_MMA(ai, bj, At, Bt) do { __builtin_amdgcn_s_setprio(1); \
        if constexpr (F8) { _Pragma("unroll") for (int m = 0; m < 4; ++m) _Pragma("unroll") for (int n = 0; n < 2; ++n) \
            asm volatile("v_mfma_scale_f32_16x16x128_f8f6f4 %0, %1, %2, %0, %3, %3 op_sel_hi:[0,0,0]" : "+v"(acc[ai][bj][m][n]) : "v"(PG8_CAT(Bt[n])), "v"(PG8_CAT(At[m])), "v"(f8one)); } \
        else { _Pragma("unroll") for (int m = 0; m < 4; ++m) _Pragma("unroll") for (int n = 0; n < 2; ++n) _Pragma("unroll") for (int k = 0; k < 2; ++k) \
            acc[ai][bj][m][n] = __builtin_amdgcn_mfma_f32_16x16x32_bf16(Bt[n][k], At[m][k], acc[ai][bj][m][n], 0, 0, 0); } \
        __builtin_amdgcn_s_setprio(0); } while (0)
#define PG8_WAIT_V(n) asm volatile("s_waitcnt vmcnt(" #n ")" ::: "memory")
#define PG8_WAIT_L(n) asm volatile("s_waitcnt lgkmcnt(" #n ")" ::: "memory")
#define PG8_BAR __builtin_amdgcn_s_barrier()
#define PG8_SCHED __builtin_amdgcn_sched_barrier(0)
    Unit cur, nxt; int ui = 0;
    if (!S.next(0, cur)) return;
    const int f8one = 127;
    f32x4 acc[2][2][4][2];
#pragma unroll
    for (int a = 0; a < 2; ++a)
#pragma unroll
        for (int b = 0; b < 2; ++b)
#pragma unroll
            for (int m = 0; m < 4; ++m)
#pragma unroll
                for (int n = 0; n < 2; ++n) acc[a][b][m][n] = (f32x4){0.f, 0.f, 0.f, 0.f};
    bf16x8 At[4][2], B0[2][2], B1[2][2];
    const char* cA = (const char*)g.A + (size_t)cur.pm * tstepA; const char* cB = (const char*)g.Bt + (size_t)cur.pn * tstepB;
    PG8_STAGE(PG8_SB(0, 0), cB, voffB); PG8_STAGE(PG8_SB(0, 1), cB + hstepB, voffB); PG8_STAGE(PG8_SA(0, 0), cA, voffA); PG8_STAGE(PG8_SA(0, 1), cA + hstepA, voffA);
    if (wr == 1) PG8_BAR;
    PG8_WAIT_V(2); PG8_BAR;
    PG8_STAGE(PG8_SB(1, 0), cB + kstep, voffB); PG8_STAGE(PG8_SA(1, 0), cA + kstep, voffA); PG8_STAGE(PG8_SB(1, 1), cB + hstepB + kstep, voffB);
    PG8_WAIT_V(6); PG8_BAR;
    for (;;) {
        const bool has_next = S.next(ui + 1, nxt);
        const char* nA = has_next ? (const char*)g.A + (size_t)nxt.pm * tstepA : cA; const char* nB = has_next ? (const char*)g.Bt + (size_t)nxt.pn * tstepB : cB;
        for (int t = 0; t < nt; t += 2) {
            const bool last = (t == nt - 2);
            const char* a1 = cA + (size_t)(t + 1) * kstep;
            const char* a2 = last ? nA : cA + (size_t)(t + 2) * kstep; const char* b2 = last ? nB : cB + (size_t)(t + 2) * kstep;
            const char* a3 = a2 + kstep; const char* b3 = b2 + kstep;
            PG8_LDB(B0, 0, 0); PG8_LDB(B1, 0, 1); PG8_SCHED; PG8_LDA(At, 0, 0); PG8_STAGE(PG8_SA(1, 1), a1 + hstepA, voffA);
            PG8_WAIT_V(8); PG8_WAIT_L(0); PG8_BAR; PG8_MMA(0, 0, At, B0); PG8_MMA(0, 1, At, B1); PG8_BAR; PG8_SCHED;
            PG8_LDA(At, 0, 1); PG8_STAGE(PG8_SB(0, 0), b2, voffB); PG8_STAGE(PG8_SB(0, 1), b2 + hstepB, voffB); PG8_STAGE(PG8_SA(0, 0), a2, voffA);
            PG8_WAIT_V(8); PG8_WAIT_L(0); PG8_BAR; PG8_MMA(1, 0, At, B0); PG8_MMA(1, 1, At, B1); PG8_BAR; PG8_SCHED;
            PG8_LDB(B0, 1, 0); PG8_LDB(B1, 1, 1); PG8_SCHED; PG8_LDA(At, 1, 0); PG8_STAGE(PG8_SA(0, 1), a2 + hstepA, voffA);
            PG8_WAIT_V(8); PG8_WAIT_L(0); PG8_BAR; PG8_MMA(0, 0, At, B0); PG8_MMA(0, 1, At, B1); PG8_BAR; PG8_SCHED;
            PG8_LDA(At, 1, 1); PG8_STAGE(PG8_SB(1, 0), b3, voffB); PG8_STAGE(PG8_SB(1, 1), b3 + hstepB, voffB); PG8_STAGE(PG8_SA(1, 0), a3, voffA);
            PG8_WAIT_V(8); PG8_WAIT_L(0); PG8_BAR; PG8_MMA(1, 0, At, B0); PG8_MMA(1, 1, At, B1); PG8_BAR; PG8_SCHED;
        }
        if constexpr (ALIGN_EPI) { if (wr == 0) PG8_BAR; }
        if constexpr (F8) { asm volatile("s_nop 15\n\ts_nop 15" ::: "memory"); }
        E(acc, cur, wr, wc, fr, fq);
        if (!has_next) break;
#pragma unroll
        for (int a = 0; a < 2; ++a)
#pragma unroll
            for (int b = 0; b < 2; ++b)
#pragma unroll
                for (int m = 0; m < 4; ++m)
#pragma unroll
                    for (int n = 0; n < 2; ++n) acc[a][b][m][n] = (f32x4){0.f, 0.f, 0.f, 0.f};
        cur = nxt; cA = nA; cB = nB; ++ui;
        if constexpr (ALIGN_EPI) { if (wr == 1) PG8_BAR; }
    }
    PG8_WAIT_V(0);
    if constexpr (!ALIGN_EPI) { if (wr == 0) PG8_BAR; }
    PG8_BAR;
#undef PG8_SA
#undef PG8_SB
#undef PG8_STAGE
#undef PG8_LDA
#undef PG8_LDB
#undef PG8_MMA
#undef PG8_CAT
#undef PG8_WAIT_V
#undef PG8_WAIT_L
#undef PG8_BAR
#undef PG8_SCHED
}
}

struct Frame {
    LAS unsigned char* lds;
    int tid, lane, wave, G, gw, ngw;
    const float* in[20];
    float* out; unsigned char* ws;
};
enum { I_X = 0, I_META, I_LN0G, I_LN0B, I_RELB, I_WIN, I_WUK, I_WUV, I_WGK2, I_BGK, I_GNG, I_WOUT, I_LN1G, I_LN1B, I_WPQ, I_SUBK, I_UTAB, I_VTAB, I_LN2G, I_LN2B };

__device__ __forceinline__ void ln_stats(f32x4 (&v)[8], float& mean, float& rstd) {
    float s = 0.f;
#pragma unroll
    for (int j = 0; j < 8; ++j) s += (v[j].x + v[j].y) + (v[j].z + v[j].w);
    mean = wave_sum(s) * (1.f / DM); float s2 = 0.f;
#pragma unroll
    for (int j = 0; j < 8; ++j) { v[j] = v[j] - mean; s2 += (v[j].x * v[j].x + v[j].y * v[j].y) + (v[j].z * v[j].z + v[j].w * v[j].w); }
    rstd = 1.f / sqrtf(wave_sum(s2) * (1.f / DM) + LN_EPS);
}
__device__ __forceinline__ void ln_load(f32x4 (&v)[8], const float* xrow, int lane) {
    const f32x4* xr = (const f32x4*)xrow + lane;
#pragma unroll
    for (int j = 0; j < 8; ++j) v[j] = xr[64 * j];
}
__device__ __forceinline__ void ln_finish_bf16(f32x4 (&v)[8], const float* g, const float* b, bf16_t* orow, int lane, unsigned* f8row, float* stats) {
    float mean, rstd; ln_stats(v, mean, rstd);
    if (stats && lane == 0) *(f32x2*)stats = (f32x2){mean, rstd};
    const f32x4* gr = (const f32x4*)g + lane; const f32x4* br = (const f32x4*)b + lane;
    u32x2* o8 = (u32x2*)orow + lane;
#pragma unroll
    for (int j = 0; j < 8; ++j) { const f32x4 gg = gr[64 * j], bb = br[64 * j]; const f32x4 y = v[j] * rstd * gg + bb;
        u32x2 w; w.x = cvtpk(y.x, y.y); w.y = cvtpk(y.z, y.w); o8[64 * j] = w;
        if (f8row) { int q = 0; q = __builtin_amdgcn_cvt_pk_fp8_f32(y.x, y.y, q, false); q = __builtin_amdgcn_cvt_pk_fp8_f32(y.z, y.w, q, true); f8row[lane + 64 * j] = (unsigned)q; } }
}
__device__ __forceinline__ void ln_finish_f32(f32x4 (&v)[8], const float* g, const float* b, float* orow, int lane) {
    float mean, rstd; ln_stats(v, mean, rstd);
    const f32x4* gr = (const f32x4*)g + lane; const f32x4* br = (const f32x4*)b + lane;
    f32x4* o = (f32x4*)orow + lane;
#pragma unroll
    for (int j = 0; j < 8; ++j) { const f32x4 gg = gr[64 * j], bb = br[64 * j]; o[64 * j] = v[j] * rstd * gg + bb; }
}
__device__ __forceinline__ void transpose_item(const float* W, int N, bf16_t* WT, int ldt, int row_off, float scale, LAS float* scr, int item, int lane) {
    const int nblk = N / 32, kb = item / nblk, nb = item % nblk, k0 = 64 * kb, n0 = 32 * nb;
#pragma unroll
    for (int i = 0; i < 32; ++i) { const int kk = 2 * i + (lane >> 5); scr[kk * 33 + (lane & 31)] = W[(size_t)(k0 + kk) * N + n0 + (lane & 31)]; }
    LDS_WAIT(); asm volatile("" ::: "memory");
    const int c = lane & 7;
#pragma unroll
    for (int j = 0; j < 4; ++j) { const int n = (lane >> 3) + 8 * j; const LAS float* s = scr + (8 * c) * 33 + n;
        u32x4 o; o.x = cvtpk(s[0 * 33] * scale, s[1 * 33] * scale); o.y = cvtpk(s[2 * 33] * scale, s[3 * 33] * scale); o.z = cvtpk(s[4 * 33] * scale, s[5 * 33] * scale); o.w = cvtpk(s[6 * 33] * scale, s[7 * 33] * scale);
        *(u32x4*)(WT + (size_t)(row_off + n0 + n) * ldt + k0 + 8 * c) = o; }
    LDS_WAIT(); asm volatile("" ::: "memory");
}
__device__ __forceinline__ void transpose_item_f8(const float* W, int N, unsigned char* WT, size_t ldt, float scale, LAS float* scr, int item, int lane) {
    const int nblk = N / 32, kb = item / nblk, nb = item % nblk, k0 = 64 * kb, n0 = 32 * nb;
#pragma unroll
    for (int i = 0; i < 32; ++i) { const int kk = 2 * i + (lane >> 5); scr[kk * 33 + (lane & 31)] = W[(size_t)(k0 + kk) * N + n0 + (lane & 31)]; }
    LDS_WAIT(); asm volatile("" ::: "memory");
    const int c = lane & 7;
#pragma unroll
    for (int j = 0; j < 4; ++j) { const int n = (lane >> 3) + 8 * j; const LAS float* s = scr + (8 * c) * 33 + n;
        int w0 = 0, w1 = 0;
        w0 = __builtin_amdgcn_cvt_pk_fp8_f32(s[0 * 33] * scale, s[1 * 33] * scale, w0, false); w0 = __builtin_amdgcn_cvt_pk_fp8_f32(s[2 * 33] * scale, s[3 * 33] * scale, w0, true);
        w1 = __builtin_amdgcn_cvt_pk_fp8_f32(s[4 * 33] * scale, s[5 * 33] * scale, w1, false); w1 = __builtin_amdgcn_cvt_pk_fp8_f32(s[6 * 33] * scale, s[7 * 33] * scale, w1, true);
        *(u32x2*)(WT + (size_t)(n0 + n) * ldt + k0 + 8 * c) = (u32x2){(unsigned)w0, (unsigned)w1}; }
    LDS_WAIT(); asm volatile("" ::: "memory");
}
__device__ __forceinline__ void convert_f32_f8(const float* src, unsigned char* dst, float scale, size_t n8, size_t i0, size_t stride) {
    for (size_t i = i0; i < n8; i += 4 * stride) { f32x4 a[4], b[4];
#pragma unroll
        for (int k = 0; k < 4; ++k) { a[k] = ((const f32x4*)src)[2 * (i + k * stride)]; b[k] = ((const f32x4*)src)[2 * (i + k * stride) + 1]; }
#pragma unroll
        for (int k = 0; k < 4; ++k) { const f32x4 x = a[k] * scale, y = b[k] * scale; int w0 = 0, w1 = 0;
            w0 = __builtin_amdgcn_cvt_pk_fp8_f32(x.x, x.y, w0, false); w0 = __builtin_amdgcn_cvt_pk_fp8_f32(x.z, x.w, w0, true);
            w1 = __builtin_amdgcn_cvt_pk_fp8_f32(y.x, y.y, w1, false); w1 = __builtin_amdgcn_cvt_pk_fp8_f32(y.z, y.w, w1, true);
            ((u32x2*)dst)[i + k * stride] = (u32x2){(unsigned)w0, (unsigned)w1}; } }
}
__device__ __forceinline__ void convert_f32_bf16(const float* src, bf16_t* dst, size_t n8, size_t i0, size_t stride) {
    for (size_t i = i0; i < n8; i += stride) { const f32x4 a = ((const f32x4*)src)[2 * i], b = ((const f32x4*)src)[2 * i + 1];
        u32x4 w; w.x = cvtpk(a.x, a.y); w.y = cvtpk(a.z, a.w); w.z = cvtpk(b.x, b.y); w.w = cvtpk(b.z, b.w); ((u32x4*)dst)[i] = w; }
}
__device__ __forceinline__ int t5_bucket(int rel) {
    const int n = rel < 0 ? -rel : rel;
    const int f = n < 8 ? n : (n < 12 ? 8 : (n < 16 ? 9 : (n < 23 ? 10 : (n < 32 ? 11 : (n < 46 ? 12 : (n < 64 ? 13 : (n < 91 ? 14 : 15)))))));
    return (rel > 0 ? 16 : 0) + f;
}
constexpr float WPQ_S = 64.f;
constexpr int BT_OFF = 2080, BT_N = 2144;

__device__ __forceinline__ void p0_prologue(Frame& F) {
    LAS float* scr = (LAS float*)(F.lds + F.wave * 8704);
    bf16_t* H0 = (bf16_t*)(F.ws + WS_H0);
    { f32x4 cur[8], nxt[8];
      if (F.gw < T + NMETA) ln_load(cur, F.gw < T ? F.in[I_X] + (size_t)F.gw * DM : F.in[I_META] + (size_t)(F.gw - T) * DM, F.lane);
      for (int m = F.gw; m < T + NMETA; m += F.ngw) { const int m2 = m + F.ngw;
          if (m2 < T + NMETA) ln_load(nxt, m2 < T ? F.in[I_X] + (size_t)m2 * DM : F.in[I_META] + (size_t)(m2 - T) * DM, F.lane);
          ln_finish_bf16(cur, F.in[I_LN0G], F.in[I_LN0B], H0 + (size_t)m * DM, F.lane, nullptr, m < T ? (float*)(F.ws + WS_ST0) + 2 * (size_t)m : nullptr);
#pragma unroll
          for (int j = 0; j < 8; ++j) cur[j] = nxt[j]; } }
    { u32x4* z = (u32x4*)(H0 + (size_t)(T + NMETA) * DM); const size_t n = (size_t)(TM - T - NMETA) * DM / 8;
      for (size_t i = (size_t)F.gw * 64 + F.lane; i < n; i += (size_t)F.ngw * 64) z[i] = (u32x4){0u, 0u, 0u, 0u}; }
    constexpr int I_IN = (DM / 64) * (INC / 32), I_O = (DM / 64) * (DM / 32), I_KV = 8 * (256 / 64) * (128 / 32);
    constexpr int NITEMS = I_IN + 2 * I_O + 2 * I_KV;
    for (int it = F.gw; it < NITEMS; it += F.ngw) {
        int r = it;
        if (r < I_IN) { transpose_item(F.in[I_WIN], INC, (bf16_t*)(F.ws + WS_WIN), DM, 0, 1.f, scr, r, F.lane); continue; } r -= I_IN;
        if (r < I_O) { transpose_item(F.in[I_WOUT], DM, (bf16_t*)(F.ws + WS_WO), DM, 0, 1.f, scr, r, F.lane); continue; } r -= I_O;
        if (r < I_O) { transpose_item(F.in[I_WPQ], DM, (bf16_t*)(F.ws + WS_WPQ), DM, 0, 1.f, scr, r, F.lane); continue; } r -= I_O;
        if (r < I_KV) { const int h = r / 16; transpose_item(F.in[I_WUK] + (size_t)h * 256 * 128, 128, (bf16_t*)(F.ws + WS_WKV), 256, h * 128, 0.08838834764831845f * LOG2E, scr, r % 16, F.lane); continue; } r -= I_KV;
        { const int h = r / 16; transpose_item(F.in[I_WUV] + (size_t)h * 256 * 128, 128, (bf16_t*)(F.ws + WS_WKV), 256, 1024 + h * 128, 1.f, scr, r % 16, F.lane); }
    }
    convert_f32_bf16(F.in[I_SUBK], (bf16_t*)(F.ws + WS_SKB), (size_t)16 * 128 * 128 / 8, (size_t)F.gw * 64 + F.lane, (size_t)F.ngw * 64);
    { float* bt = (float*)(F.ws + WS_BT);
      for (int i = F.gw * 64 + F.lane; i < 8 * BT_N; i += F.ngw * 64) { const int h = i / BT_N, rel = i % BT_N - BT_OFF; bt[i] = F.in[I_RELB][t5_bucket(rel) * 8 + h] * LOG2E; } }
}

__device__ __forceinline__ void kv_meta(Frame& F) {
    const bf16_t* PROJ = (const bf16_t*)(F.ws + WS_PROJ); const bf16_t* WKV = (const bf16_t*)(F.ws + WS_WKV); bf16_t* KVP = (bf16_t*)(F.ws + WS_KVP);
    const int l16 = F.lane & 15, q4 = F.lane >> 4;
    for (int j = F.gw; j < 128; j += F.ngw) {
        f32x4 acc = {0.f, 0.f, 0.f, 0.f};
#pragma unroll
        for (int s = 0; s < 8; ++s) acc = __builtin_amdgcn_mfma_f32_16x16x32_bf16(*(const bf16x8*)(PROJ + (size_t)(T + l16) * INP + C_CKV + 32 * s + 8 * q4), *(const bf16x8*)(WKV + (size_t)(16 * j + l16) * 256 + 32 * s + 8 * q4), acc, 0, 0, 0);
#pragma unroll
        for (int r = 0; r < 4; ++r) KVP[(size_t)(T + 4 * q4 + r) * 2048 + 16 * j + l16] = f2bf(acc[r]);
    }
    { u32x4* z = (u32x4*)(KVP + (size_t)(T + NMETA) * 2048); const int n = 48 * 2048 / 8;
      for (int i = F.gw * 64 + F.lane; i < n; i += F.ngw * 64) z[i] = (u32x4){0u, 0u, 0u, 0u}; }
}
constexpr int IDX_POOL_TILES = 33;
__device__ __forceinline__ void idx_dma(Frame& F, int b, int nrt, int first, int last) {
    const bf16_t* PROJ = (const bf16_t*)(F.ws + WS_PROJ);
    const int lane = F.lane;
    for (int t = first + F.wave; t < last; t += 8) {
#pragma unroll
        for (int i = 0; i < 4; ++i) { const int p = i * 64 + lane, key = p >> 3, ch = (p & 7) ^ ((key >> 1) & 7);
            const size_t krow = t < nrt ? (size_t)(b * SEQ + 32 * t + key) : (size_t)(T + key);
            __builtin_amdgcn_global_load_lds((const unsigned*)(PROJ + krow * INP + C_IK + 8 * ch), (LAS unsigned*)(F.lds + (t - first) * 4096 + i * 1024), 16, 0, 0); }
    }
}
__device__ __forceinline__ void idx_phase(Frame& F) {
    const bf16_t* PROJ = (const bf16_t*)(F.ws + WS_PROJ);
    unsigned* BM = (unsigned*)(F.ws + WS_BM);
    const int lane = F.lane, n = lane & 31, hi = lane >> 5, w = F.wave;
    const float NINF = -__builtin_inff();
    const int nunits = NB * 128;
    int u = blockIdx.x;
    if (u < nunits) { const int b = u >> 7, gr = u & 127, g = ((b >> 1) & 1) ? 127 - gr : gr, nrt = 2 * ((g >> 2) + 1); idx_dma(F, b, nrt, 0, min(nrt + 1, IDX_POOL_TILES)); }
    for (; u < nunits; u += F.G) {
        const int b = u >> 7, gr = u & 127, g = ((b >> 1) & 1) ? 127 - gr : gr, c = g >> 2, nrt = 2 * (c + 1), ntile = nrt + 1;
        const int q0 = 16 * g + 2 * w;
        bf16x8 af[4];
#pragma unroll
        for (int s2 = 0; s2 < 4; ++s2) af[s2] = *(const bf16x8*)(PROJ + (size_t)(b * SEQ + q0 + (n >> 4)) * INP + C_IQ + (n & 15) * 64 + 16 * s2 + 8 * hi);
        float iw0[8], iw1[8];
#pragma unroll
        for (int r = 0; r < 8; ++r) { const int h = (r & 3) + 8 * (r >> 2) + 4 * hi;
            iw0[r] = bf2f(PROJ[(size_t)(b * SEQ + q0) * INP + C_IW + h]); iw1[r] = bf2f(PROJ[(size_t)(b * SEQ + q0 + 1) * INP + C_IW + h]); }
        float v[66];
        const LAS unsigned char* rb = F.lds + n * 128;
        const int sw = (n >> 1) & 7;
#define IDX_TILE(t_, slot_) do { const int tt = (t_); \
            f32x16 acc = {}; \
            _Pragma("unroll") for (int s2 = 0; s2 < 4; ++s2) acc = __builtin_amdgcn_mfma_f32_32x32x16_bf16(af[s2], *(const LAS bf16x8*)(rb + (slot_) * 4096 + (((2 * s2 + hi) ^ sw) << 4)), acc, 0, 0, 0); \
            float p0 = 0.f, p1 = 0.f; \
            _Pragma("unroll") for (int r = 0; r < 8; ++r) { p0 += fmaxf(acc[r], 0.f) * iw0[r]; p1 += fmaxf(acc[8 + r], 0.f) * iw1[r]; } \
            const auto rr = __builtin_amdgcn_permlane32_swap(__float_as_uint(p0), __float_as_uint(p1), false, false); \
            float tot = __uint_as_float(rr[0]) + __uint_as_float(rr[1]); \
            if (tt > nrt || (tt == nrt && n >= NMETA)) tot = NINF; \
            v[t_] = tot; } while (0)
        asm volatile("s_waitcnt vmcnt(0)" ::: "memory"); __syncthreads();
#pragma unroll
        for (int t = 0; t < 34; t += 2) { v[t] = NINF; v[t + 1] = NINF; if (t < ntile && t < IDX_POOL_TILES) { IDX_TILE(t, t); if (t + 1 < IDX_POOL_TILES) IDX_TILE(t + 1, t + 1); } }
        __syncthreads();
        if (ntile > IDX_POOL_TILES) {
            idx_dma(F, b, nrt, IDX_POOL_TILES, ntile);
            asm volatile("s_waitcnt vmcnt(0)" ::: "memory"); __syncthreads();
#pragma unroll
            for (int t = 34; t < 66; t += 2) { v[t] = NINF; v[t + 1] = NINF; }
            IDX_TILE(33, 0);
#pragma unroll
            for (int t = 34; t < 66; t += 2) { if (t < ntile) { IDX_TILE(t, t - IDX_POOL_TILES); if (t + 1 < 65) IDX_TILE(t + 1, t + 1 - IDX_POOL_TILES); } }
            __syncthreads();
        } else {
#pragma unroll
            for (int t = 34; t < 66; ++t) v[t] = NINF;
        }
#undef IDX_TILE
        { const int u2 = u + F.G; if (u2 < nunits) { const int b2 = u2 >> 7, gr2 = u2 & 127, g2 = ((b2 >> 1) & 1) ? 127 - gr2 : gr2, nrt2 = 2 * ((g2 >> 2) + 1); idx_dma(F, b2, nrt2, 0, min(nrt2 + 1, IDX_POOL_TILES)); } }
        float thr = -3.0e38f;
        if (c >= 3) {
            float mn = __builtin_inff(), mx = NINF;
#pragma unroll
            for (int t = 0; t < 65; ++t) { mx = fmaxf(mx, v[t]); mn = fminf(mn, v[t] > NINF ? v[t] : mn); }
#pragma unroll
            for (int o = 1; o < 32; o <<= 1) { mn = fminf(mn, __shfl_xor(mn, o)); mx = fmaxf(mx, __shfl_xor(mx, o)); }
            float lo = mn, hh = mx; bool done = false; thr = mn;
            for (int it = 0; it < 64; ++it) {
                const float mid = 0.5f * lo + 0.5f * hh;
                if (!done && !(mid > lo && mid < hh)) { thr = lo; done = true; }
                if (__all(done)) break;
                int cnt = 0;
#pragma unroll
                for (int t = 0; t < 22; ++t) cnt += (v[t] >= mid) ? 1 : 0;
                if (nrt >= 22) {
#pragma unroll
                    for (int t = 22; t < 44; ++t) cnt += (v[t] >= mid) ? 1 : 0; }
                if (nrt >= 44) {
#pragma unroll
                    for (int t = 44; t < 65; ++t) cnt += (v[t] >= mid) ? 1 : 0; }
#pragma unroll
                for (int o = 1; o < 32; o <<= 1) cnt += __shfl_xor(cnt, o);
                if (!done) { if (cnt == 256) { thr = mid; done = true; } else if (cnt > 256) lo = mid; else hh = mid; }
            }
            if (!done) thr = lo;
        }
        unsigned w0 = 0u, w1 = 0u, w2 = 0u;
#pragma unroll
        for (int t = 0; t < 65; ++t) {
            const unsigned long long bal = __ballot(v[t] >= thr && v[t] > NINF);
            const unsigned mine = hi ? (unsigned)(bal >> 32) : (unsigned)bal;
            const bool ismeta = (t == nrt);
            if (t < 32) { if (!ismeta && n == t) w0 = mine; } else if (t < 64) { if (!ismeta && n == t - 32) w1 = mine; }
            if (ismeta && n == 0) w2 = mine;
        }
        unsigned* bm = BM + (size_t)(b * SEQ + q0 + hi) * 66;
        bm[n] = w0; bm[32 + n] = w1; if (n < 2) bm[64 + n] = w2;
    }
    asm volatile("s_waitcnt vmcnt(0)" ::: "memory"); __syncthreads();
}

namespace att {
constexpr int SHM_V = 64 * 128 * 2, SHM_K = 64 * 128 * 2;
constexpr int OFF_V = 0, OFF_K = 2 * SHM_V, OFF_WS = OFF_K + 2 * SHM_K, OFF_BT = OFF_WS + NWAVES * 256, BTW = 384, BT_ZERO = 320;
#define KSWZ(row, colB) ((row) * 256 + ((colB) ^ (((row) & 7) << 4)))
__device__ __forceinline__ int v_st(int k, int c) { const int kk = (k & ~0xC) | ((k & 4) << 1) | ((k & 8) >> 1); return ((kk >> 3) * 4 + (c >> 5)) * 512 + ((kk & 7) * 32 + (c & 31)) * 2; }
__device__ __forceinline__ int v_rd_base(int lane) { return ((lane & 3) << 3) | (((lane >> 2) & 3) << 6) | (((lane >> 4) & 1) << 5) | (((lane >> 5) & 1) << 8); }
constexpr int v_rd_off(int d0, int ks, int half) { return d0 * 512 + ks * 4096 + half * 2048; }
template <int OFF> __device__ __forceinline__ s16x4 tr_read(int vb) { s16x4 r; asm volatile("ds_read_b64_tr_b16 %0, %1 offset:%2" : "=&v"(r) : "v"(vb), "i"(OFF) : "memory"); return r; }
template <int D0> __device__ __forceinline__ void pv_one(f32x16& od, int vb, bf16x8 pa0, bf16x8 pa1, bf16x8 pa2, bf16x8 pa3) {
    const s16x4 l0 = tr_read<v_rd_off(D0, 0, 0)>(vb), h0 = tr_read<v_rd_off(D0, 0, 1)>(vb), l1 = tr_read<v_rd_off(D0, 1, 0)>(vb), h1 = tr_read<v_rd_off(D0, 1, 1)>(vb);
    const s16x4 l2 = tr_read<v_rd_off(D0, 2, 0)>(vb), h2 = tr_read<v_rd_off(D0, 2, 1)>(vb), l3 = tr_read<v_rd_off(D0, 3, 0)>(vb), h3 = tr_read<v_rd_off(D0, 3, 1)>(vb);
    asm volatile("s_waitcnt lgkmcnt(0)" ::: "memory"); SBAR();
#define PK(L, H) (bf16x8){L[0], L[1], L[2], L[3], H[0], H[1], H[2], H[3]}
    od = __builtin_amdgcn_mfma_f32_32x32x16_bf16(pa0, PK(l0, h0), od, 0, 0, 0);
    od = __builtin_amdgcn_mfma_f32_32x32x16_bf16(pa1, PK(l1, h1), od, 0, 0, 0);
    od = __builtin_amdgcn_mfma_f32_32x32x16_bf16(pa2, PK(l2, h2), od, 0, 0, 0);
    od = __builtin_amdgcn_mfma_f32_32x32x16_bf16(pa3, PK(l3, h3), od, 0, 0, 0);
#undef PK
}
__device__ __forceinline__ void qkt(f32x16& p0, f32x16& p1, const LAS unsigned char* Ks, const bf16x8* qr, int r32, int hi) {
    p0 = f32x16{}; p1 = f32x16{};
#pragma unroll
    for (int d0 = 0; d0 < 8; ++d0) { const int cb = (d0 * 16 + hi * 8) * 2;
        const bf16x8 b0 = *(const LAS bf16x8*)(Ks + KSWZ(r32, cb));
        const bf16x8 b1 = *(const LAS bf16x8*)(Ks + KSWZ(32 + r32, cb));
        p0 = __builtin_amdgcn_mfma_f32_32x32x16_bf16(b0, qr[d0], p0, 0, 0, 0);
        p1 = __builtin_amdgcn_mfma_f32_32x32x16_bf16(b1, qr[d0], p1, 0, 0, 0); }
}
template <bool NEAR>
__device__ __forceinline__ void tile_sm(f32x16& p0, f32x16& p1, float& m_reg, float& l_reg, float& alpha, bf16x8& pa0, bf16x8& pa1, bf16x8& pa2, bf16x8& pa3,
                                        float cb, const LAS float* btl, unsigned mlo, unsigned mhi, int hi) {
    if (NEAR) {
#pragma unroll
        for (int r = 0; r < 16; ++r) { p0[r] += btl[(r & 3) + 8 * (r >> 2)]; p1[r] += btl[32 + (r & 3) + 8 * (r >> 2)]; }
    }
    float pmax = p0[0];
#pragma unroll
    for (int r = 1; r < 16; ++r) pmax = fmaxf(pmax, p0[r]);
#pragma unroll
    for (int r = 0; r < 16; ++r) pmax = fmaxf(pmax, p1[r]);
    { const auto rr = __builtin_amdgcn_permlane32_swap(__float_as_uint(pmax), __float_as_uint(pmax), false, false); pmax = fmaxf(__uint_as_float(rr[0]), __uint_as_float(rr[1])); }
    if (!NEAR) pmax += cb;
    const float mn = fmaxf(m_reg, pmax); alpha = __builtin_amdgcn_exp2f(m_reg - mn); m_reg = mn;
    const float off = (NEAR ? 0.f : cb) - mn;
    const unsigned w0 = mlo >> (4 * hi), w1 = mhi >> (4 * hi);
    float ps = 0.f;
#pragma unroll
    for (int r = 0; r < 16; ++r) { const int pos = (r & 3) + 8 * (r >> 2);
        const float e0 = __builtin_amdgcn_exp2f(p0[r] + off), e1 = __builtin_amdgcn_exp2f(p1[r] + off);
        p0[r] = __uint_as_float(__float_as_uint(e0) & (unsigned)__builtin_amdgcn_sbfe((int)w0, pos, 1));
        p1[r] = __uint_as_float(__float_as_uint(e1) & (unsigned)__builtin_amdgcn_sbfe((int)w1, pos, 1));
        ps += p0[r] + p1[r]; }
    { const auto rr = __builtin_amdgcn_permlane32_swap(__float_as_uint(ps), __float_as_uint(ps), false, false); ps = __uint_as_float(rr[0]) + __uint_as_float(rr[1]); }
    l_reg = l_reg * alpha + ps;
#define PK4(P, BASE, OUT) do { unsigned a0 = cvtpk(P[BASE + 0], P[BASE + 1]), a1 = cvtpk(P[BASE + 2], P[BASE + 3]);   \
    unsigned b0 = cvtpk(P[BASE + 4], P[BASE + 5]), b1 = cvtpk(P[BASE + 6], P[BASE + 7]);                              \
    auto r0 = __builtin_amdgcn_permlane32_swap(a0, b0, false, false); auto r1 = __builtin_amdgcn_permlane32_swap(a1, b1, false, false); \
    u32x4 w = {r0[0], r1[0], r0[1], r1[1]}; OUT = *reinterpret_cast<bf16x8*>(&w); } while (0)
    PK4(p0, 0, pa0); PK4(p0, 8, pa1); PK4(p1, 0, pa2); PK4(p1, 8, pa3);
#undef PK4
}
__device__ __forceinline__ void attn_unit(Frame& F, int b, int h, int qb) {
    const bf16_t* PROJ = (const bf16_t*)(F.ws + WS_PROJ); const bf16_t* KVP = (const bf16_t*)(F.ws + WS_KVP);
    const unsigned long long* BM = (const unsigned long long*)(F.ws + WS_BM);
    const float* BT = (const float*)(F.ws + WS_BT);
    bf16_t* YM = (bf16_t*)(F.ws + WS_YMIX);
    LAS unsigned char* lds = F.lds;
    const int tid = F.tid, wid = F.wave, lane = F.lane, r32 = lane & 31, hi = lane >> 5;
    LAS unsigned char* V_lds = lds + OFF_V; LAS unsigned char* K_lds = lds + OFF_K;
    LAS float* wsl = (LAS float*)(lds + OFF_WS) + wid * 64; LAS float* li_l = wsl; LAS float* al_l = wsl + 32;
    LAS float* btw = (LAS float*)(lds + OFF_BT) + wid * BTW;
    for (int i = lane; i < BTW; i += 64) btw[i] = BT[h * BT_N + (i - BT_ZERO + BT_OFF)];
    const int q0w = 256 * qb + 32 * wid, q = q0w + r32;
    const size_t tq = (size_t)(b * SEQ + q);
    const int nreal = 4 * (qb + 1), NT = nreal + 1;
    float m_reg = -1e30f, l_reg = 0.f; f32x16 o[4] = {}; bf16x8 qr[8];
    { const bf16_t* Qw = PROJ + tq * INP + C_AQ + h * 128 + hi * 8;
#pragma unroll
      for (int d0 = 0; d0 < 8; ++d0) qr[d0] = *(const bf16x8*)(Qw + d0 * 16); }
    const int sr = tid >> 4, sc = (tid & 15) * 8, vst0 = v_st(sr, sc), vst1 = v_st(32 + sr, sc);
    const int vb0 = (int)(unsigned)(size_t)V_lds + v_rd_base(lane);
    bf16x8 vs0, vs1, ks0, ks1;
    const bf16_t* Kh = KVP + h * 128 + sc; const bf16_t* Vh = KVP + 1024 + h * 128 + sc;
#define A_SLOAD(j) do { const size_t kb_ = (j) < nreal ? (size_t)(b * SEQ + 64 * (j)) : (size_t)T; \
    vs0 = *(const bf16x8*)(Vh + (kb_ + sr) * 2048); vs1 = *(const bf16x8*)(Vh + (kb_ + 32 + sr) * 2048); \
    ks0 = *(const bf16x8*)(Kh + (kb_ + sr) * 2048); ks1 = *(const bf16x8*)(Kh + (kb_ + 32 + sr) * 2048); } while (0)
#define A_SWRITE(bf) do { *(LAS bf16x8*)(V_lds + (bf) * SHM_V + vst0) = vs0; *(LAS bf16x8*)(V_lds + (bf) * SHM_V + vst1) = vs1; \
    *(LAS bf16x8*)(K_lds + (bf) * SHM_K + KSWZ(sr, sc * 2)) = ks0; *(LAS bf16x8*)(K_lds + (bf) * SHM_K + KSWZ(32 + sr, sc * 2)) = ks1; } while (0)
#define A_RESC(a) do { if (__any((a) < 1.f)) { if (hi == 0) al_l[r32] = (a); asm volatile("s_waitcnt lgkmcnt(0)" ::: "memory"); \
    _Pragma("unroll") for (int d = 0; d < 4; ++d) _Pragma("unroll") for (int r = 0; r < 16; ++r) o[d][r] *= al_l[crow(r, hi)]; } } while (0)
    const float cbfar = BT[h * BT_N + (-200 + BT_OFF)];
    A_SLOAD(0); unsigned long long mk = BM[tq * 33 + 0];
    VM_WAIT(); A_SWRITE(0); __syncthreads();
    for (int j = 0; j < NT; ++j) {
        const int cur = j & 1; const bool more = (j + 1 < NT);
        unsigned long long mkn = 0ull;
        if (more) { A_SLOAD(j + 1); mkn = BM[tq * 33 + ((j + 1) < nreal ? (j + 1) : 32)]; }
        f32x16 p0, p1; float alpha; bf16x8 pa0, pa1, pa2, pa3;
        qkt(p0, p1, K_lds + cur * SHM_K, qr, r32, hi);
        const bool meta = (j >= nreal);
        const bool nearT = meta ? (q0w < 96) : (64 * j + 63 - q0w > -91);
        if (nearT) { const int base = (meta ? (-16 - q) : (64 * j - q)) + BT_ZERO + 4 * hi;
            tile_sm<true>(p0, p1, m_reg, l_reg, alpha, pa0, pa1, pa2, pa3, 0.f, btw + base, (unsigned)mk, (unsigned)(mk >> 32), hi); }
        else tile_sm<false>(p0, p1, m_reg, l_reg, alpha, pa0, pa1, pa2, pa3, cbfar, btw, (unsigned)mk, (unsigned)(mk >> 32), hi);
        A_RESC(alpha);
        const int vb = vb0 + cur * SHM_V;
        pv_one<0>(o[0], vb, pa0, pa1, pa2, pa3); pv_one<1>(o[1], vb, pa0, pa1, pa2, pa3); pv_one<2>(o[2], vb, pa0, pa1, pa2, pa3); pv_one<3>(o[3], vb, pa0, pa1, pa2, pa3);
        if (more) { VM_WAIT(); A_SWRITE(cur ^ 1); }
        mk = mkn;
        __syncthreads();
    }
    if (hi == 0) li_l[r32] = l_reg; asm volatile("s_waitcnt lgkmcnt(0)" ::: "memory");
    float rli[16];
#pragma unroll
    for (int r = 0; r < 16; ++r) rli[r] = __builtin_amdgcn_rcpf(li_l[crow(r, hi)]);
    bf16_t* Ow = YM + (size_t)(b * SEQ + q0w) * DM + h * 128;
#pragma unroll
    for (int r = 0; r < 16; ++r) { const int orow = crow(r, hi);
#pragma unroll
        for (int d0 = 0; d0 < 4; ++d0) Ow[(size_t)orow * DM + d0 * 32 + r32] = f2bf(o[d0][r] * rli[r]); }
    __syncthreads();
#undef A_SLOAD
#undef A_SWRITE
#undef A_RESC
}
__device__ __forceinline__ void attn_phase(Frame& F) {
    for (int u = blockIdx.x; u < 512; u += F.G) { const int bh = (u >> 2) & 63, p = u & 3, qb = (u >= 256) ? 7 - p : p;
        attn_unit(F, bh >> 3, bh & 7, qb); }
}
#undef KSWZ
}

__device__ __forceinline__ size_t gla_row(int b, int c, int i) { return c == 0 ? (size_t)(T + i - 48) : (size_t)(b * SEQ + (c - 1) * 64 + i); }
__device__ __forceinline__ void gla_prep_unit(Frame& F, int b, int h, int c) {
    const bf16_t* PROJ = (const bf16_t*)(F.ws + WS_PROJ);
    bf16_t* QT = (bf16_t*)(F.ws + WS_QT); bf16_t* KTT = (bf16_t*)(F.ws + WS_KTT); bf16_t* VT = (bf16_t*)(F.ws + WS_VT); bf16_t* AT = (bf16_t*)(F.ws + WS_AT);
    float* EB = (float*)(F.ws + WS_EB);
    LAS unsigned char* lds = F.lds;
    LAS bf16_t* Qs = (LAS bf16_t*)lds;
    LAS bf16_t* Ks = (LAS bf16_t*)(lds + 64 * 136 * 2);
    LAS float* tot = (LAS float*)(lds + 2 * 64 * 136 * 2);
    LAS float* grs = tot + 512;
    LAS float* Bs = grs + 1024;
    const int tid = F.tid, d = tid & 127, ig = tid >> 7, G = b * NCH + c;
    const int dg = tid & 15, i2 = tid >> 4;
    u32x4 gl = {0u, 0u, 0u, 0u};
    if (tid < 128) { const int i = tid >> 1; if (c > 0 || i >= 48) gl = *(const u32x4*)(PROJ + gla_row(b, c, i) * INP + C_GR + 8 * (tid & 1)); }
    u32x4 qw[2], kw[2];
#pragma unroll
    for (int p = 0; p < 2; ++p) { const int i = i2 + 32 * p; qw[p] = (u32x4){0u, 0u, 0u, 0u}; kw[p] = qw[p];
        if (c > 0 || i >= 48) { const size_t row = gla_row(b, c, i); qw[p] = *(const u32x4*)(PROJ + row * INP + C_GQ + h * 128 + 8 * dg); kw[p] = *(const u32x4*)(PROJ + row * INP + C_GK + h * 128 + 8 * dg); } }
    unsigned vpk[16];
    { const int v = tid & 255, ih = tid >> 8;
#pragma unroll
      for (int j = 0; j < 16; ++j) { const int i0 = 32 * ih + 2 * j; unsigned lo = 0u, hi2 = 0u;
          if (c > 0 || i0 >= 48) lo = PROJ[gla_row(b, c, i0) * INP + C_GV + h * 256 + v];
          if (c > 0 || i0 + 1 >= 48) hi2 = PROJ[gla_row(b, c, i0 + 1) * INP + C_GV + h * 256 + v];
          vpk[j] = lo | (hi2 << 16); } }
    float wv[16];
#pragma unroll
    for (int r = 0; r < 16; ++r) wv[r] = F.in[I_WGK2][r * 512 + h * 128 + d];
    const float bg = F.in[I_BGK][h * 128 + d];
    if (tid < 128) { LAS float* gp = grs + (tid >> 1) * 16 + 8 * (tid & 1);
        gp[0] = bflo(gl.x); gp[1] = bfhi(gl.x); gp[2] = bflo(gl.y); gp[3] = bfhi(gl.y); gp[4] = bflo(gl.z); gp[5] = bfhi(gl.z); gp[6] = bflo(gl.w); gp[7] = bfhi(gl.w); }
    __syncthreads();
    float bl[16]; float run = 0.f;
#pragma unroll
    for (int ii = 0; ii < 16; ++ii) { const int i = 16 * ig + ii; const bool valid = (c > 0) || (i >= 48);
        const f32x4 a0 = *(const LAS f32x4*)(grs + i * 16), a1 = *(const LAS f32x4*)(grs + i * 16 + 4), a2 = *(const LAS f32x4*)(grs + i * 16 + 8), a3 = *(const LAS f32x4*)(grs + i * 16 + 12);
        float x = bg + a0.x * wv[0] + a0.y * wv[1] + a0.z * wv[2] + a0.w * wv[3] + a1.x * wv[4] + a1.y * wv[5] + a1.z * wv[6] + a1.w * wv[7]
                     + a2.x * wv[8] + a2.y * wv[9] + a2.z * wv[10] + a2.w * wv[11] + a3.x * wv[12] + a3.y * wv[13] + a3.z * wv[14] + a3.w * wv[15];
        const float gk = valid ? (fminf(x, 0.f) - __logf(1.f + __expf(-fabsf(x)))) * (1.f / 16.f) : 0.f;
        run += gk; bl[ii] = run; }
    tot[ig * 128 + d] = run;
    __syncthreads();
    float offs = 0.f, blast = 0.f;
#pragma unroll
    for (int gI = 0; gI < 4; ++gI) { const float tv = tot[gI * 128 + d]; blast += tv; if (gI < ig) offs += tv; }
#pragma unroll
    for (int ii = 0; ii < 16; ++ii) Bs[(16 * ig + ii) * 132 + d] = bl[ii] + offs;
    if (ig == 0) EB[(size_t)G * 512 + h * 128 + d] = __expf(blast);
    __syncthreads();
#pragma unroll
    for (int p = 0; p < 2; ++p) { const int i = i2 + 32 * p;
        const f32x4 b0 = *(const LAS f32x4*)(Bs + i * 132 + 8 * dg), b1 = *(const LAS f32x4*)(Bs + i * 132 + 8 * dg + 4);
        const float bb[8] = {b0.x, b0.y, b0.z, b0.w, b1.x, b1.y, b1.z, b1.w};
        const unsigned qq[4] = {qw[p].x, qw[p].y, qw[p].z, qw[p].w}, kk[4] = {kw[p].x, kw[p].y, kw[p].z, kw[p].w};
        unsigned qo[4], ko[4];
#pragma unroll
        for (int j = 0; j < 4; ++j) { const float e0 = __expf(bb[2 * j]), e1 = __expf(bb[2 * j + 1]);
            qo[j] = cvtpk(bflo(qq[j]) * e0 * 0.08838834764831845f, bfhi(qq[j]) * e1 * 0.08838834764831845f);
            ko[j] = cvtpk(bflo(kk[j]) * __builtin_amdgcn_rcpf(e0), bfhi(kk[j]) * __builtin_amdgcn_rcpf(e1)); }
        const u32x4 qv4 = {qo[0], qo[1], qo[2], qo[3]}, kv4 = {ko[0], ko[1], ko[2], ko[3]};
        *(u32x4*)(QT + ((size_t)G * 64 + i) * 512 + h * 128 + 8 * dg) = qv4;
        *(LAS u32x4*)(Qs + i * 136 + 8 * dg) = qv4; *(LAS u32x4*)(Ks + i * 136 + 8 * dg) = kv4; }
    { const int v = tid & 255, ih = tid >> 8; u32x4* dst = (u32x4*)(VT + ((size_t)G * 1024 + h * 256 + v) * 64 + 32 * ih);
#pragma unroll
      for (int j = 0; j < 4; ++j) dst[j] = (u32x4){vpk[4 * j], vpk[4 * j + 1], vpk[4 * j + 2], vpk[4 * j + 3]}; }
    __syncthreads();
    { const int jg = ig; unsigned pk[8];
#pragma unroll
      for (int j = 0; j < 8; ++j) pk[j] = (unsigned)Ks[(16 * jg + 2 * j) * 136 + d] | ((unsigned)Ks[(16 * jg + 2 * j + 1) * 136 + d] << 16);
      u32x4* dst = (u32x4*)(KTT + (((size_t)G * 4 + h) * 128 + d) * 64 + 16 * jg);
      dst[0] = (u32x4){pk[0], pk[1], pk[2], pk[3]}; dst[1] = (u32x4){pk[4], pk[5], pk[6], pk[7]}; }
    if (F.wave < 4) { const int w = F.wave, ib = (w == 0 || w == 3) ? 0 : 1, jb = (w == 2 || w == 3) ? 1 : 0; const int n = F.lane & 31, hi = F.lane >> 5;
        f32x16 acc = {};
        if (w < 3) {
#pragma unroll
            for (int s = 0; s < 8; ++s) { const bf16x8 a = *(const LAS bf16x8*)(Qs + (32 * ib + n) * 136 + 16 * s + 8 * hi), bb = *(const LAS bf16x8*)(Ks + (32 * jb + n) * 136 + 16 * s + 8 * hi);
                acc = __builtin_amdgcn_mfma_f32_32x32x16_bf16(a, bb, acc, 0, 0, 0); } }
        bf16_t* dst = AT + (((size_t)G * 4 + h) * 64) * 64;
#pragma unroll
        for (int r = 0; r < 16; ++r) { const int i = 32 * ib + crow(r, hi), j = 32 * jb + n; dst[i * 64 + j] = f2bf(j <= i ? acc[r] : 0.f); } }
    __syncthreads();
}
__device__ __forceinline__ void gla_prep_phase(Frame& F) {
    for (int u = blockIdx.x; u < NB * NCH * 4; u += F.G) { const int h = u & 3, bc = u >> 2; gla_prep_unit(F, bc / NCH, h, bc % NCH); }
}
struct GlaOps { bf16x8 ka0, ka1, v00, v01, v10, v11; f32x4 eb; };
__device__ __forceinline__ void gla_load_ops(GlaOps& o, const bf16_t* KTT, const bf16_t* VT, const float* EB, int G, int h, int vs, int w, int l16, int q4) {
    const bf16_t* kt = KTT + (((size_t)G * 4 + h) * 128 + 16 * w + l16) * 64 + 8 * q4;
    const bf16_t* vt = VT + ((size_t)G * 1024 + h * 256 + 32 * vs + l16) * 64 + 8 * q4;
    o.ka0 = *(const bf16x8*)(kt); o.ka1 = *(const bf16x8*)(kt + 32);
    o.v00 = *(const bf16x8*)(vt); o.v01 = *(const bf16x8*)(vt + 32); o.v10 = *(const bf16x8*)(vt + 16 * 64); o.v11 = *(const bf16x8*)(vt + 16 * 64 + 32);
    o.eb = *(const f32x4*)(EB + (size_t)G * 512 + h * 128 + 16 * w + 4 * q4);
}
__device__ __forceinline__ void gla_scan_task(Frame& F, int b, int h, int vs, int w) {
    const bf16_t* KTT = (const bf16_t*)(F.ws + WS_KTT); const bf16_t* VT = (const bf16_t*)(F.ws + WS_VT); const float* EB = (const float*)(F.ws + WS_EB);
    bf16_t* SST = (bf16_t*)(F.ws + WS_SST);
    const int lane = F.lane, l16 = lane & 15, q4 = lane >> 4, G0 = b * NCH;
    f32x4 S0 = {0.f, 0.f, 0.f, 0.f}, S1 = {0.f, 0.f, 0.f, 0.f};
    for (int c0 = 0; c0 < NCH - 1; c0 += 6) {
        GlaOps o[6];
#pragma unroll
        for (int k = 0; k < 6; ++k) if (c0 + k < NCH - 1) gla_load_ops(o[k], KTT, VT, EB, G0 + c0 + k, h, vs, w, l16, q4);
        u32x2 r0[6], r1[6];
#pragma unroll
        for (int k = 0; k < 6; ++k) if (c0 + k < NCH - 1) {
            S0 = __builtin_amdgcn_mfma_f32_16x16x32_bf16(o[k].ka0, o[k].v00, S0, 0, 0, 0); S0 = __builtin_amdgcn_mfma_f32_16x16x32_bf16(o[k].ka1, o[k].v01, S0, 0, 0, 0);
            S1 = __builtin_amdgcn_mfma_f32_16x16x32_bf16(o[k].ka0, o[k].v10, S1, 0, 0, 0); S1 = __builtin_amdgcn_mfma_f32_16x16x32_bf16(o[k].ka1, o[k].v11, S1, 0, 0, 0);
            S0 = S0 * o[k].eb; S1 = S1 * o[k].eb;
            r0[k] = (u32x2){cvtpk(S0[0], S0[1]), cvtpk(S0[2], S0[3])}; r1[k] = (u32x2){cvtpk(S1[0], S1[1]), cvtpk(S1[2], S1[3])}; }
#pragma unroll
        for (int k = 0; k < 6; ++k) if (c0 + k < NCH - 1) {
            bf16_t* so = SST + (((size_t)(G0 + c0 + k) * 4 + h) * 256 + 32 * vs + l16) * 128 + 16 * w + 4 * q4;
            *(u32x2*)(so) = r0[k]; *(u32x2*)(so + 16 * 128) = r1[k]; }
    }
}
__device__ __forceinline__ void gla_scan_phase(Frame& F) {
    for (int u = F.gw; u < NB * 4 * 8 * 8; u += F.ngw) gla_scan_task(F, u >> 8, (u >> 6) & 3, (u >> 3) & 7, u & 7);
}
__device__ __forceinline__ void gla_out_unit(Frame& F, int b, int h, int c) {
    const bf16_t* PROJ = (const bf16_t*)(F.ws + WS_PROJ); const bf16_t* QT = (const bf16_t*)(F.ws + WS_QT); const bf16_t* AT = (const bf16_t*)(F.ws + WS_AT);
    const bf16_t* VT = (const bf16_t*)(F.ws + WS_VT); const bf16_t* SST = (const bf16_t*)(F.ws + WS_SST);
    bf16_t* YM = (bf16_t*)(F.ws + WS_YMIX);
    LAS float* part = (LAS float*)F.lds;
    const int w = F.wave, lane = F.lane, l16 = lane & 15, q4 = lane >> 4, G = b * NCH + c;
    bf16x8 sb[2][4], vb[2][2];
#pragma unroll
    for (int vh = 0; vh < 2; ++vh) { const bf16_t* sp = SST + (((size_t)(G - 1) * 4 + h) * 256 + 32 * w + 16 * vh + l16) * 128 + 8 * q4;
        const bf16_t* vp = VT + ((size_t)G * 1024 + h * 256 + 32 * w + 16 * vh + l16) * 64 + 8 * q4;
#pragma unroll
        for (int s2 = 0; s2 < 4; ++s2) sb[vh][s2] = *(const bf16x8*)(sp + 32 * s2);
        vb[vh][0] = *(const bf16x8*)(vp); vb[vh][1] = *(const bf16x8*)(vp + 32); }
    u32x4 xg[4];
#pragma unroll
    for (int k = 0; k < 4; ++k) xg[k] = *(const u32x4*)(PROJ + (size_t)(b * SEQ + (c - 1) * 64 + (lane >> 2) + 16 * k) * INP + C_GO + h * 256 + 32 * w + 8 * (lane & 3));
    f32x4 oa[4][2];
#pragma unroll
    for (int it = 0; it < 4; ++it) { const bf16_t* qp = QT + ((size_t)G * 64 + 16 * it + l16) * 512 + h * 128 + 8 * q4; const bf16_t* ap = AT + (((size_t)G * 4 + h) * 64 + 16 * it + l16) * 64 + 8 * q4;
        const bf16x8 q0 = *(const bf16x8*)(qp), q1 = *(const bf16x8*)(qp + 32), q2 = *(const bf16x8*)(qp + 64), q3 = *(const bf16x8*)(qp + 96), a0 = *(const bf16x8*)(ap), a1 = *(const bf16x8*)(ap + 32);
#pragma unroll
        for (int vh = 0; vh < 2; ++vh) { f32x4 a = {0.f, 0.f, 0.f, 0.f};
            a = __builtin_amdgcn_mfma_f32_16x16x32_bf16(q0, sb[vh][0], a, 0, 0, 0); a = __builtin_amdgcn_mfma_f32_16x16x32_bf16(q1, sb[vh][1], a, 0, 0, 0);
            a = __builtin_amdgcn_mfma_f32_16x16x32_bf16(q2, sb[vh][2], a, 0, 0, 0); a = __builtin_amdgcn_mfma_f32_16x16x32_bf16(q3, sb[vh][3], a, 0, 0, 0);
            a = __builtin_amdgcn_mfma_f32_16x16x32_bf16(a0, vb[vh][0], a, 0, 0, 0); a = __builtin_amdgcn_mfma_f32_16x16x32_bf16(a1, vb[vh][1], a, 0, 0, 0);
            oa[it][vh] = a; } }
#pragma unroll
    for (int it = 0; it < 4; ++it)
#pragma unroll
        for (int r = 0; r < 4; ++r) { float ss = oa[it][0][r] * oa[it][0][r] + oa[it][1][r] * oa[it][1][r];
            ss += __shfl_xor(ss, 1); ss += __shfl_xor(ss, 2); ss += __shfl_xor(ss, 4); ss += __shfl_xor(ss, 8);
            if (l16 == 0) part[(16 * it + 4 * q4 + r) * 8 + w] = ss; }
    __syncthreads();
    const float g0 = F.in[I_GNG][32 * w + l16], g1 = F.in[I_GNG][32 * w + 16 + l16];
    LAS float* wt = (LAS float*)(F.lds + 2048) + w * (64 * 36);
#pragma unroll
    for (int it = 0; it < 4; ++it)
#pragma unroll
        for (int r = 0; r < 4; ++r) { const int i = 16 * it + 4 * q4 + r;
            const f32x4 p0 = *(const LAS f32x4*)(part + i * 8), p1 = *(const LAS f32x4*)(part + i * 8 + 4);
            const float rstd = 1.f / sqrtf(((p0.x + p0.y) + (p0.z + p0.w) + (p1.x + p1.y) + (p1.z + p1.w)) * (1.f / 256.f) + LN_EPS);
            wt[i * 36 + l16] = oa[it][0][r] * rstd * g0; wt[i * 36 + 16 + l16] = oa[it][1][r] * rstd * g1; }
    LDS_WAIT();
#pragma unroll
    for (int k = 0; k < 4; ++k) { const int i = (lane >> 2) + 16 * k, c8 = 8 * (lane & 3);
        const f32x4 t0 = *(const LAS f32x4*)(wt + i * 36 + c8), t1 = *(const LAS f32x4*)(wt + i * 36 + c8 + 4);
        const float tv[8] = {t0.x, t0.y, t0.z, t0.w, t1.x, t1.y, t1.z, t1.w}; const unsigned xw[4] = {xg[k].x, xg[k].y, xg[k].z, xg[k].w};
        unsigned yo[4];
#pragma unroll
        for (int j = 0; j < 4; ++j) { const float x0 = bflo(xw[j]), x1 = bfhi(xw[j]);
            yo[j] = cvtpk(tv[2 * j] * (x0 / (1.f + __expf(-x0))), tv[2 * j + 1] * (x1 / (1.f + __expf(-x1)))); }
        *(u32x4*)(YM + (size_t)(b * SEQ + (c - 1) * 64 + i) * DM + 1024 + h * 256 + 32 * w + c8) = (u32x4){yo[0], yo[1], yo[2], yo[3]}; }
    __syncthreads();
}
__device__ __forceinline__ void gla_out_phase(Frame& F) {
    for (int u = blockIdx.x; u < NB * 4 * 32; u += F.G) gla_out_unit(F, u >> 7, (u >> 5) & 3, 1 + (u & 31));
}

__device__ __forceinline__ int f2key(float f) { const int b = __float_as_int(f); return b ^ ((b >> 31) & 0x7fffffff); }
__device__ __forceinline__ float key2f(int k) { return __int_as_float(k ^ ((k >> 31) & 0x7fffffff)); }
#define CEX(a, b) do { const int _t = max(a, b); b = min(a, b); a = _t; } while (0)
__device__ __forceinline__ void sort16_desc(int (&x)[16]) {
#pragma unroll
    for (int k = 2; k <= 16; k <<= 1)
#pragma unroll
        for (int j = k >> 1; j > 0; j >>= 1)
#pragma unroll
            for (int i = 0; i < 16; ++i) { const int l = i ^ j; if (l > i) { if ((i & k) == 0) CEX(x[i], x[l]); else CEX(x[l], x[i]); } }
}
__device__ __forceinline__ void merge16_desc(int (&a)[16], const int (&b)[16]) {
#pragma unroll
    for (int i = 0; i < 16; ++i) a[i] = max(a[i], b[15 - i]);
#pragma unroll
    for (int j = 8; j > 0; j >>= 1)
#pragma unroll
        for (int i = 0; i < 16; ++i) { const int l = i ^ j; if (l > i) CEX(a[i], a[l]); }
}
__device__ __forceinline__ void peer_topk_task(Frame& F, int t0, int h) {
    const bf16_t* QH = (const bf16_t*)(F.ws + WS_QH); const bf16_t* SKB = (const bf16_t*)(F.ws + WS_SKB);
    unsigned short* EIDX = (unsigned short*)(F.ws + WS_EIDX); float* GATE = (float*)(F.ws + WS_GATE);
    const int lane = F.lane, r32 = lane & 31, hi = lane >> 5;
    int L1[16], L2[16];
#pragma unroll
    for (int c = 0; c < 2; ++c) {
        f32x16 acc[4] = {};
        const bf16_t* qp = QH + (size_t)(t0 + r32) * DM + (h * 2 + c) * 128 + 8 * hi;
        const bf16_t* kp = SKB + ((size_t)(h * 2 + c) * 128 + r32) * 128 + 8 * hi;
#pragma unroll
        for (int s = 0; s < 8; ++s) { const bf16x8 bq = *(const bf16x8*)(qp + 16 * s);
#pragma unroll
            for (int nt = 0; nt < 4; ++nt) acc[nt] = __builtin_amdgcn_mfma_f32_32x32x16_bf16(*(const bf16x8*)(kp + (size_t)nt * 32 * 128 + 16 * s), bq, acc[nt], 0, 0, 0); }
        int L[16], M[16];
#pragma unroll
        for (int nt = 0; nt < 4; ++nt) {
#pragma unroll
            for (int r = 0; r < 16; ++r) { const int n = 32 * nt + (r & 3) + 8 * (r >> 2) + 4 * hi; M[r] = (f2key(acc[nt][r]) & ~127) | n; }
            sort16_desc(M);
            if (nt == 0) {
#pragma unroll
                for (int i = 0; i < 16; ++i) L[i] = M[i];
            } else merge16_desc(L, M);
        }
#pragma unroll
        for (int i = 0; i < 16; ++i) M[i] = __shfl_xor(L[i], 32);
        merge16_desc(L, M);
#pragma unroll
        for (int i = 0; i < 16; ++i) { if (c == 0) L1[i] = L[i]; else L2[i] = L[i]; }
    }
    int Lc[16], M[16]; int nm = 0;
#pragma unroll
    for (int j = 0; j < 16; ++j) { const float sm = key2f(L1[0] & ~127) + key2f(L2[j] & ~127); Lc[j] = (f2key(sm) & ~16383) | ((L1[0] & 127) << 7) | (L2[j] & 127); }
#pragma unroll
    for (int i = 1; i < 16; ++i)
#pragma unroll
        for (int j = 0; j < 16; ++j) if ((i + 1) * (j + 1) <= 16) { const float sm = key2f(L1[i] & ~127) + key2f(L2[j] & ~127);
            M[nm & 15] = (f2key(sm) & ~16383) | ((L1[i] & 127) << 7) | (L2[j] & 127); ++nm;
            if ((nm & 15) == 0) { sort16_desc(M); merge16_desc(Lc, M); } }
    { M[2] = M[3] = M[4] = M[5] = M[6] = M[7] = M[8] = M[9] = M[10] = M[11] = M[12] = M[13] = M[14] = M[15] = (int)0x80000000;
      if (M[0] < M[1]) { const int t_ = M[0]; M[0] = M[1]; M[1] = t_; }
      merge16_desc(Lc, M); }
    float ev[16]; float esum = 0.f; const float vmax = key2f(Lc[0] & ~16383);
#pragma unroll
    for (int k = 0; k < 16; ++k) { ev[k] = __expf(key2f(Lc[k] & ~16383) - vmax); esum += ev[k]; }
    const float rs = 1.f / esum;
    const size_t t = (size_t)(t0 + r32);
#pragma unroll
    for (int k = 0; k < 16; ++k) if ((k >> 3) == hi) { EIDX[t * 128 + h * 16 + k] = (unsigned short)(Lc[k] & 16383); GATE[t * 128 + h * 16 + k] = ev[k] * rs; }
}
__device__ __forceinline__ void peer_topk_phase(Frame& F) {
    for (int u = F.gw; u < (T / 32) * 8; u += F.ngw) peer_topk_task(F, (u >> 3) * 32, u & 7);
}

__device__ __forceinline__ void peer_mask_phase(Frame& F) {
    const unsigned short* EIDX = (const unsigned short*)(F.ws + WS_EIDX); const float* GATE = (const float*)(F.ws + WS_GATE);
    unsigned char* C8 = F.ws + WS_C; const int lane = F.lane;
    for (int r0 = 4 * F.gw; r0 < T; r0 += 4 * F.ngw) {
        int e0[4], e1[4]; float g0[4], g1[4], t0[4], t1[4]; unsigned a0[4], a1[4];
#pragma unroll
        for (int i = 0; i < 4; ++i) { const size_t t = (size_t)(r0 + i); e0[i] = EIDX[t * 128 + lane]; e1[i] = EIDX[t * 128 + 64 + lane]; g0[i] = GATE[t * 128 + lane]; g1[i] = GATE[t * 128 + 64 + lane]; }
#pragma unroll
        for (int i = 0; i < 4; ++i) { const unsigned char* crow = C8 + (size_t)(r0 + i) * NEXP; a0[i] = crow[e0[i]]; a1[i] = crow[e1[i]]; }
#pragma unroll
        for (int i = 0; i < 4; ++i) { float s0 = 0.f, s1 = 0.f;
            for (int k = 0; k < 64; ++k) { const int ek = __builtin_amdgcn_readlane(e0[i], k); const float gk = __uint_as_float(__builtin_amdgcn_readlane(__float_as_uint(g0[i]), k));
                s0 += (e0[i] == ek) ? gk : 0.f; s1 += (e1[i] == ek) ? gk : 0.f; }
            for (int k = 0; k < 64; ++k) { const int ek = __builtin_amdgcn_readlane(e1[i], k); const float gk = __uint_as_float(__builtin_amdgcn_readlane(__float_as_uint(g1[i]), k));
                s0 += (e0[i] == ek) ? gk : 0.f; s1 += (e1[i] == ek) ? gk : 0.f; }
            t0[i] = s0; t1[i] = s1; }
        asm volatile("s_waitcnt vmcnt(0)" ::: "memory");
        unsigned char o0[4], o1[4];
#pragma unroll
        for (int i = 0; i < 4; ++i) {
            const float x0 = __builtin_amdgcn_cvt_f32_fp8((int)a0[i], 0) * (1.f / pg8::PEER_SA), x1 = __builtin_amdgcn_cvt_f32_fp8((int)a1[i], 0) * (1.f / pg8::PEER_SA);
            o0[i] = (unsigned char)(__builtin_amdgcn_cvt_pk_fp8_f32(t0[i] * pg8::PEER_SC * pg8::gelu_exact(x0), 0.f, 0, false) & 255);
            o1[i] = (unsigned char)(__builtin_amdgcn_cvt_pk_fp8_f32(t1[i] * pg8::PEER_SC * pg8::gelu_exact(x1), 0.f, 0, false) & 255); }
#pragma unroll
        for (int i = 0; i < 4; ++i) { u32x4* z = (u32x4*)(C8 + (size_t)(r0 + i) * NEXP);
#pragma unroll
            for (int j = 0; j < 16; ++j) z[j * 64 + lane] = (u32x4){0u, 0u, 0u, 0u}; }
        asm volatile("s_waitcnt vmcnt(0)" ::: "memory");
#pragma unroll
        for (int i = 0; i < 4; ++i) { unsigned char* crow = C8 + (size_t)(r0 + i) * NEXP; crow[e0[i]] = o0[i]; crow[e1[i]] = o1[i]; }
    }
}

struct Args { const float* in[20]; float* out; unsigned char* ws; int ph_lo, ph_hi; };
constexpr int N_PHASES = 16;
__global__ void __launch_bounds__(NTHREADS, 2) mk_fwd(Args args) {
    extern __shared__ __attribute__((aligned(16))) unsigned char lds_raw[];
    Frame F;
    F.lds = (LAS unsigned char*)lds_raw;
    F.tid = threadIdx.x; F.lane = F.tid & 63; F.wave = __builtin_amdgcn_readfirstlane(F.tid >> 6);
    F.G = gridDim.x; F.gw = blockIdx.x * NWAVES + F.wave; F.ngw = F.G * NWAVES;
#pragma unroll
    for (int i = 0; i < 20; ++i) F.in[i] = args.in[i];
    F.out = args.out; F.ws = args.ws;
    volatile LAS unsigned* lctl = (volatile LAS unsigned*)(F.lds + LDSCTL_OFF);
    if (F.tid < 64) lctl[F.tid] = 0u;
    __syncthreads();
    unsigned* ctl = (unsigned*)(F.ws + WS_CTL);
    const int lo = args.ph_lo, hi = args.ph_hi;
    XcdBarrier bar; bar.bar = ctl + 1024; bar.x = 0; bar.st = lctl + 8;
    if (hi - lo > 1) bar = xcd_barrier_post(ctl + 1024, lctl + 8);
#define IN(k) (lo <= (k) && (k) < hi)
#define SEAM(k) do { if (IN(k) && IN((k) + 1)) xcd_barrier(bar); } while (0)
#define LOCAL(k) do { if (IN(k) && IN((k) + 1)) __syncthreads(); } while (0)
    const int bid = blockIdx.x;
#define REFRESH() do { int t_ = threadIdx.x; asm volatile("" : "+v"(t_)); F.tid = t_; F.lane = t_ & 63; } while (0)

    if (IN(0)) { REFRESH(); p0_prologue(F); } SEAM(0);
    if (IN(1)) { REFRESH();
        pg8::Gemm g{(const bf16_t*)(F.ws + WS_H0), (const bf16_t*)(F.ws + WS_WIN), TM, INP, DM, DM, DM}; pg8::StaticOrder S; S.init(TM, INP, F.G, bid);
        pg8::EpiBf16 E{(bf16_t*)(F.ws + WS_PROJ), INP, 1.f};
        pg8::gemm_phase<pg8::EpiBf16, true>(F.lds, g, S, E);
    } SEAM(1);
    if (IN(2)) { REFRESH();
        kv_meta(F);
        pg8::Gemm g{(const bf16_t*)(F.ws + WS_PROJ) + C_CKV, (const bf16_t*)(F.ws + WS_WKV), T, 2048, 256, INP, 256}; pg8::StaticOrder S; S.init(T, 2048, F.G, bid);
        pg8::EpiBf16 E{(bf16_t*)(F.ws + WS_KVP), 2048, 1.f};
        pg8::gemm_phase<pg8::EpiBf16, true>(F.lds, g, S, E);
    } LOCAL(2);
    if (IN(3)) { REFRESH(); idx_phase(F); } LOCAL(3);
    if (IN(4)) { REFRESH(); gla_prep_phase(F); } SEAM(4);
    if (IN(5)) { REFRESH(); gla_scan_phase(F); } LOCAL(5);
    if (IN(6)) { REFRESH(); att::attn_phase(F); } SEAM(6);
    if (IN(7)) { REFRESH(); gla_out_phase(F); } SEAM(7);
    if (IN(8)) { REFRESH();
        pg8::Gemm g{(const bf16_t*)(F.ws + WS_YMIX), (const bf16_t*)(F.ws + WS_WO), T, DM, DM, DM, DM}; pg8::StaticOrder S; S.init(T, DM, F.G, bid);
        pg8::EpiResLn0 E{F.out, DM, F.in[I_X], (const float*)(F.ws + WS_ST0), F.in[I_LN0G], F.in[I_LN0B], ALPHA};
        pg8::gemm_phase<pg8::EpiResLn0, true>(F.lds, g, S, E);
    } SEAM(8);
    if (IN(9)) { REFRESH();
        bf16_t* H1 = (bf16_t*)(F.ws + WS_H1); unsigned* H1F8 = (unsigned*)(F.ws + WS_H1F8);
        { f32x4 cur[8], nxt[8]; ln_load(cur, F.out + (size_t)F.gw * DM, F.lane);
          for (int m = F.gw; m < T; m += F.ngw) { const int m2 = m + F.ngw; if (m2 < T) ln_load(nxt, F.out + (size_t)m2 * DM, F.lane);
              ln_finish_bf16(cur, F.in[I_LN1G], F.in[I_LN1B], H1 + (size_t)m * DM, F.lane, H1F8 + (size_t)m * (DM / 4), nullptr);
#pragma unroll
              for (int j = 0; j < 8; ++j) cur[j] = nxt[j]; } }
        convert_f32_f8(F.in[I_UTAB], F.ws + WS_UF8, pg8::PEER_SU, (size_t)NEXP * DM / 8, (size_t)F.gw * 64 + F.lane, (size_t)F.ngw * 64);
        { LAS float* scr = (LAS float*)(F.lds + F.wave * 8704);
          for (int it = F.gw; it < (NEXP / 64) * (DM / 32); it += F.ngw) transpose_item_f8(F.in[I_VTAB], DM, F.ws + WS_VF8, NEXP, pg8::PEER_SV, scr, it, F.lane); }
    } SEAM(9);
    if (IN(10)) { REFRESH();
        pg8::Gemm g{(const bf16_t*)(F.ws + WS_H1), (const bf16_t*)(F.ws + WS_WPQ), T, DM, DM, DM, DM}; pg8::StaticOrder S; S.init(T, DM, F.G, bid);
        pg8::EpiBf16 E{(bf16_t*)(F.ws + WS_QH), DM, 1.f};
        pg8::gemm_phase<pg8::EpiBf16, true>(F.lds, g, S, E);
    } SEAM(10);
    if (IN(11)) { REFRESH(); peer_topk_phase(F); } LOCAL(11);
    if (IN(12)) { REFRESH();
        pg8::Gemm g{(const bf16_t*)(F.ws + WS_H1F8), (const bf16_t*)(F.ws + WS_UF8), T, NEXP, DM / 2, DM / 2, DM / 2}; pg8::StaticOrder S; S.init(T, NEXP, F.G, bid);
        pg8::EpiF8 E{F.ws + WS_C, NEXP, pg8::PEER_SA / pg8::PEER_SU};
        pg8::gemm_phase<pg8::EpiF8, true, true>(F.lds, g, S, E);
    } SEAM(12);
    if (IN(13)) { REFRESH(); peer_mask_phase(F); } SEAM(13);
    if (IN(14)) { REFRESH();
        pg8::Gemm g{(const bf16_t*)(F.ws + WS_C), (const bf16_t*)(F.ws + WS_VF8), T, DM, NEXP / 2, NEXP / 2, NEXP / 2}; pg8::StaticOrder S; S.init(T, DM, F.G, bid);
        pg8::EpiResF32 E{F.out, DM, (const bf16_t*)(F.ws + WS_H1), DM, ALPHA, 1.f / (pg8::PEER_SC * pg8::PEER_SV)};
        pg8::gemm_phase<pg8::EpiResF32, true, true>(F.lds, g, S, E);
    } SEAM(14);
    if (IN(15)) { REFRESH(); f32x4 cur[8], nxt[8]; ln_load(cur, F.out + (size_t)F.gw * DM, F.lane);
        for (int m = F.gw; m < T; m += F.ngw) { const int m2 = m + F.ngw; if (m2 < T) ln_load(nxt, F.out + (size_t)m2 * DM, F.lane);
            ln_finish_f32(cur, F.in[I_LN2G], F.in[I_LN2B], F.out + (size_t)m * DM, F.lane);
#pragma unroll
            for (int j = 0; j < 8; ++j) cur[j] = nxt[j]; } }
#undef LOCAL
#undef REFRESH
#undef IN
#undef SEAM
}

#ifndef MK_TAILSEQ
#define MK_TAILSEQ {-1}
#endif
#ifndef MK_REPS
#define MK_REPS {1,1,1,1,1,1,1,1,1,1,1,1,1,1,1,1}
#endif
#ifndef MK_ONE_LAUNCH
#define MK_ONE_LAUNCH 1
#endif
extern "C" void kernel_launch(void* const* d_in, const int* in_sizes, int n_in, void* d_out, int out_size, void* d_ws, size_t ws_size, hipStream_t stream) {
    static int grid = 0;
    if (grid == 0) {
        if (n_in != 20 || out_size != T * DM || ws_size < WS_END) { fprintf(stderr, "kernel_launch: shape mismatch n_in %d out %d ws %zu (need %zu)\n", n_in, out_size, ws_size, (size_t)WS_END); grid = -1; return; }
        int dev = 0, cus = 0, per_cu = 0;
        if (hipGetDevice(&dev) != hipSuccess || hipDeviceGetAttribute(&cus, hipDeviceAttributeMultiprocessorCount, dev) != hipSuccess) { grid = -1; return; }
        if (hipFuncSetAttribute((const void*)mk_fwd, hipFuncAttributeMaxDynamicSharedMemorySize, LDS_BYTES) != hipSuccess) { fprintf(stderr, "kernel_launch: hipFuncSetAttribute failed\n"); grid = -1; return; }
        if (hipOccupancyMaxActiveBlocksPerMultiprocessor(&per_cu, (const void*)mk_fwd, NTHREADS, LDS_BYTES) != hipSuccess || per_cu < 1) fprintf(stderr, "kernel_launch: occupancy query says %d\n", per_cu);
        (void)hipGetLastError();
        grid = cus;
    }
    if (grid < 0) return;
    (void)hipMemsetAsync((char*)d_ws + WS_CTL, 0, CTL_ZERO_BYTES, stream);
    Args a{};
    for (int i = 0; i < 20; ++i) a.in[i] = (const float*)d_in[i];
    a.out = (float*)d_out; a.ws = (unsigned char*)d_ws;
#if MK_ONE_LAUNCH
    a.ph_lo = 0; a.ph_hi = N_PHASES;
    hipLaunchKernelGGL(mk_fwd, dim3(grid), dim3(NTHREADS), LDS_BYTES, stream, a);
#else
    static const int reps[N_PHASES] = MK_REPS; static const int tailseq[] = MK_TAILSEQ;
    for (int p = 0; p < N_PHASES; ++p) for (int r = 0; r < reps[p]; ++r) { a.ph_lo = p; a.ph_hi = p + 1; hipLaunchKernelGGL(mk_fwd, dim3(grid), dim3(NTHREADS), LDS_BYTES, stream, a); }
    for (unsigned i = 0; i < sizeof(tailseq) / sizeof(int); ++i) if (tailseq[i] >= 0) { a.ph_lo = tailseq[i]; a.ph_hi = tailseq[i] + 1; hipLaunchKernelGGL(mk_fwd, dim3(grid), dim3(NTHREADS), LDS_BYTES, stream, a); }
#endif
}
```
